# Optimizing an MI355X kernel written in HIP

```python
import math
import jax, jax.numpy as jnp
from jax import lax
import numpy as np

D_MODEL = 2048
BATCH = 2
SEQ = 4096
DEPTH = 1

CHUNK = 64
Q_BLOCK = 128
EPS = 1e-6
ROPE_THETA = 10000.0

RET_HEADS = 8
RET_QK_DIM = 128
RET_V_DIM = 256
RET_QK_W = RET_HEADS * RET_QK_DIM
RET_V_W = RET_HEADS * RET_V_DIM

MLA_HEADS = 16
Q_LORA = 512
KV_LORA = 512
QK_NOPE = 128
QK_ROPE = 64
V_HEAD = 128
MLA_QK_DIM = QK_NOPE + QK_ROPE
MLA_V_W = MLA_HEADS * V_HEAD

D_FF = 4 * D_MODEL

IN_SPLITS = (RET_QK_W, RET_QK_W, RET_V_W, RET_V_W, Q_LORA, KV_LORA, QK_ROPE, D_MODEL, D_MODEL)
N_IN = sum(IN_SPLITS)

kernel_name = "hybrid_retention_mla_gated_encoder"


def _rmsnorm(x, g):
    x32 = x.astype(jnp.float32)
    y = x32 * lax.rsqrt(jnp.mean(x32 * x32, axis=-1, keepdims=True) + EPS)
    return (y * g.astype(jnp.float32)).astype(x.dtype)


def _rope(t, positions):
    half = t.shape[-1] // 2
    inv = ROPE_THETA ** (-jnp.arange(half, dtype=jnp.float32) / half)
    ang = positions.astype(jnp.float32)[..., None] * inv
    cos = jnp.cos(ang)[:, :, None, :]
    sin = jnp.sin(ang)[:, :, None, :]
    t32 = t.astype(jnp.float32)
    t1, t2 = t32[..., :half], t32[..., half:]
    out = jnp.concatenate([t1 * cos - t2 * sin, t2 * cos + t1 * sin], axis=-1)
    return out.astype(t.dtype)


def _retention(q, k, v):
    B, S, H, dk = q.shape
    dv = v.shape[-1]
    nc = S // CHUNK
    log_gamma = jnp.log(1.0 - 2.0 ** (-5.0 - jnp.arange(H, dtype=jnp.float32)))

    def to_chunks(t):
        return t.reshape(B, nc, CHUNK, H, t.shape[-1]).transpose(1, 0, 3, 2, 4)

    pos = jnp.arange(CHUNK, dtype=jnp.float32)
    lg = log_gamma[:, None]
    intra = jnp.exp(lg[..., None] * jnp.abs(pos[:, None] - pos[None, :]))
    q_dec = jnp.exp(lg * (pos + 1.0))
    k_dec = jnp.exp(lg * (CHUNK - 1.0 - pos))
    c_dec = jnp.exp(log_gamma * CHUNK)

    def step(state, inp):
        qi, ki, vi = inp
        s = jnp.einsum('bhnd,bhmd->bhnm', qi, ki) * intra
        o = (jnp.einsum('bhnm,bhme->bhne', s, vi)
             + jnp.einsum('bhnd,bhde->bhne', qi * q_dec[..., None], state))
        state = state * c_dec[:, None, None] + jnp.einsum(
            'bhmd,bhme->bhde', ki * k_dec[..., None], vi)
        return state, o

    state0 = jnp.zeros((B, H, dk, dv), jnp.float32)
    _, o = lax.scan(step, state0, (to_chunks(q), to_chunks(k), to_chunks(v)))
    return o.transpose(1, 0, 3, 2, 4).reshape(B, S, H, dv)


def _block_causal_attention(q, k, v, scale):
    B, S, H, dqk = q.shape
    nb = S // Q_BLOCK
    qb = q.reshape(B, nb, Q_BLOCK, H, dqk).transpose(1, 0, 2, 3, 4)
    key_chunk = jnp.arange(S) // CHUNK

    def one(args):
        qi, bi = args
        q_chunk = (bi * Q_BLOCK + jnp.arange(Q_BLOCK)) // CHUNK
        mask = key_chunk[None, :] <= q_chunk[:, None]
        s = jnp.einsum('bqhd,bkhd->bhqk', qi, k,
                       preferred_element_type=jnp.float32) * scale
        s = jnp.where(mask, s, -jnp.inf)
        p = jax.nn.softmax(s, axis=-1).astype(v.dtype)
        return jnp.einsum('bhqk,bkhe->bqhe', p, v)

    o = lax.map(one, (qb, jnp.arange(nb)))
    return o.transpose(1, 0, 2, 3, 4).reshape(B, S, H, v.shape[-1])


def _mixer(u, positions, w_in, ret_norm_g, w_ret_o, q_a_norm_g, w_q_b,
           kv_a_norm_g, w_kv_b, w_mla_o, w_out):
    B, S, _ = u.shape
    proj = u @ w_in
    offs = []
    acc = 0
    for w in IN_SPLITS[:-1]:
        acc += w
        offs.append(acc)
    (r_q, r_k, r_v, r_g, c_q, c_kv, k_pe, g_ret, g_mla) = jnp.split(proj, offs, axis=-1)

    rq = _rope(r_q.reshape(B, S, RET_HEADS, RET_QK_DIM), positions).astype(jnp.float32)
    rk = _rope(r_k.reshape(B, S, RET_HEADS, RET_QK_DIM), positions).astype(jnp.float32)
    rk = rk * (RET_QK_DIM ** -0.5)
    rv = r_v.reshape(B, S, RET_HEADS, RET_V_DIM).astype(jnp.float32)
    ry = _retention(rq, rk, rv)
    mu = jnp.mean(ry, axis=-1, keepdims=True)
    var = jnp.mean(jnp.square(ry - mu), axis=-1, keepdims=True)
    ry = ((ry - mu) * lax.rsqrt(var + EPS)).reshape(B, S, RET_V_W) * ret_norm_g.astype(jnp.float32)
    ry = ry.astype(u.dtype) * jax.nn.silu(r_g)
    y_ret = ry @ w_ret_o

    q = (_rmsnorm(c_q, q_a_norm_g) @ w_q_b).reshape(B, S, MLA_HEADS, MLA_QK_DIM)
    q_nope, q_pe = q[..., :QK_NOPE], _rope(q[..., QK_NOPE:], positions)
    kv = (_rmsnorm(c_kv, kv_a_norm_g) @ w_kv_b).reshape(B, S, MLA_HEADS, QK_NOPE + V_HEAD)
    k_nope, v = kv[..., :QK_NOPE], kv[..., QK_NOPE:]
    k_pe = _rope(k_pe.reshape(B, S, 1, QK_ROPE), positions)
    qf = jnp.concatenate([q_nope, q_pe], axis=-1)
    kf = jnp.concatenate([k_nope, jnp.broadcast_to(k_pe, (B, S, MLA_HEADS, QK_ROPE))], axis=-1)
    my = _block_causal_attention(qf, kf, v, MLA_QK_DIM ** -0.5)
    y_mla = my.reshape(B, S, MLA_V_W) @ w_mla_o

    merged = jax.nn.sigmoid(g_ret) * y_ret + jax.nn.sigmoid(g_mla) * y_mla
    return merged @ w_out


def setup_inputs(seed: int = 0) -> dict:
    key = jax.random.key(seed)
    ks = jax.random.split(key, 20)
    f32 = jnp.float32

    def nrm(k, shape, fan_in):
        return jax.random.normal(k, shape, f32) * (fan_in ** -0.5)

    def gain(k, shape):
        return 1.0 + 0.02 * jax.random.normal(k, shape, f32)

    x = jax.random.normal(ks[0], (BATCH, SEQ, D_MODEL), f32)
    start = jax.random.randint(ks[1], (BATCH, 1), 0, 4096, dtype=jnp.int32)
    positions = (start + jnp.arange(SEQ, dtype=jnp.int32)[None, :]).astype(jnp.int32)
    return {
        "x": x,
        "positions": positions,
        "norm_mix_g": gain(ks[2], (DEPTH, D_MODEL)),
        "w_in": nrm(ks[3], (DEPTH, D_MODEL, N_IN), D_MODEL),
        "ret_norm_g": gain(ks[4], (DEPTH, RET_V_W)),
        "w_ret_o": nrm(ks[5], (DEPTH, RET_V_W, D_MODEL), RET_V_W),
        "q_a_norm_g": gain(ks[6], (DEPTH, Q_LORA)),
        "w_q_b": nrm(ks[7], (DEPTH, Q_LORA, MLA_HEADS * MLA_QK_DIM), Q_LORA),
        "kv_a_norm_g": gain(ks[8], (DEPTH, KV_LORA)),
        "w_kv_b": nrm(ks[9], (DEPTH, KV_LORA, MLA_HEADS * (QK_NOPE + V_HEAD)), KV_LORA),
        "w_mla_o": nrm(ks[10], (DEPTH, MLA_V_W, D_MODEL), MLA_V_W),
        "w_out": nrm(ks[11], (DEPTH, D_MODEL, D_MODEL), D_MODEL),
        "norm_mlp_g": gain(ks[12], (DEPTH, D_MODEL)),
        "w_up": nrm(ks[13], (DEPTH, D_MODEL, D_FF), D_MODEL),
        "w_down": nrm(ks[14], (DEPTH, D_FF, D_MODEL), D_FF),
        "norm_f_g": gain(ks[15], (D_MODEL,)),
    }


def reference(x, positions, norm_mix_g, w_in, ret_norm_g, w_ret_o, q_a_norm_g, w_q_b,
              kv_a_norm_g, w_kv_b, w_mla_o, w_out, norm_mlp_g, w_up, w_down, norm_f_g):
    h = x
    for l in range(DEPTH):
        u = _rmsnorm(h, norm_mix_g[l])
        h = h + _mixer(u, positions, w_in[l], ret_norm_g[l], w_ret_o[l], q_a_norm_g[l],
                       w_q_b[l], kv_a_norm_g[l], w_kv_b[l], w_mla_o[l], w_out[l])
        z = _rmsnorm(h, norm_mlp_g[l]) @ w_up[l]
        h = h + jnp.square(jax.nn.relu(z)) @ w_down[l]
    return _rmsnorm(h, norm_f_g)
```

```cpp
#include <hip/hip_runtime.h>
#include <hip/hip_bf16.h>
#include <cstdio>
#include <cstdint>

#ifndef DBG
#define DBG 0
#endif
#define NO_SSQ_TEST 0
#ifndef N_LAUNCH_SPLIT
#define N_LAUNCH_SPLIT 0
#endif

#define LAS __attribute__((address_space(3)))
#define GAS __attribute__((address_space(1)))
typedef unsigned short bf16_t;
typedef short bf16x8 __attribute__((ext_vector_type(8)));
typedef short s16x4 __attribute__((ext_vector_type(4)));
typedef float f32x4 __attribute__((ext_vector_type(4)));
typedef float f32x2 __attribute__((ext_vector_type(2)));
typedef float f32x16 __attribute__((ext_vector_type(16)));
typedef unsigned u32x4 __attribute__((ext_vector_type(4)));
typedef unsigned u32x2 __attribute__((ext_vector_type(2)));

constexpr int T = 8192, SEQ = 4096, DM = 2048, DFF = 8192;
constexpr int N_IN = 11328, N1P = 11520;
constexpr float EPS = 1e-6f;
constexpr float C2Q = 0.07216878364870322f * 1.4426950408889634f;
constexpr float RK_SCALE = 0.08838834764831845f;
constexpr int LO_RQ = 0, LO_RK = 1024, LO_RV = 2048, LO_RG = 4096, LO_CQ = 6144, LO_CKV = 6656, LO_KPE = 7168, LO_GRET = 7232, LO_GMLA = 9280;

constexpr size_t MiB = 1u << 20;
constexpr size_t WS_CTL = 0, CTL_BYTES = 1 * MiB;
constexpr size_t WS_WRM = 1 * MiB, WS_WO = 17 * MiB, WS_WQ = 25 * MiB, WS_WKV = 28 * MiB;
constexpr size_t WS_RC64 = 32 * MiB, WS_RS64 = 34 * MiB, WS_RC32 = 36 * MiB, WS_RS32 = 37 * MiB;
constexpr size_t WS_WI = 38 * MiB, WS_U = 83 * MiB, WS_KVL = 38 * MiB, WS_RYMY = 38 * MiB, WS_H1B = 38 * MiB;
constexpr size_t WS_RQ = 115 * MiB, WS_RK = 131 * MiB, WS_RV = 147 * MiB, WS_SG = 179 * MiB, WS_KPE = 211 * MiB, WS_CQ = 212 * MiB, WS_CKV = 220 * MiB, WS_S = 212 * MiB;
constexpr size_t WS_QN = 228 * MiB, WS_QP = 260 * MiB, WS_KN = 276 * MiB, WS_V = 308 * MiB;
constexpr size_t WS_MERGED = 115 * MiB, WS_WU = 147 * MiB, WS_WD = 179 * MiB, WS_HMID = 211 * MiB;
constexpr size_t WS_END = 340 * MiB;
constexpr int CW_ERR = 0, CW_BAR = 1024;
constexpr size_t CTL_SSQ_Q = 64 * 1024, CTL_SSQ_KV = 96 * 1024, CTL_SSQ_H1 = 128 * 1024, CTL_SSQ_H2 = 160 * 1024;

constexpr int RING_BYTES = 131072, MISC_OFF = RING_BYTES + 320, LDS_BYTES = 147456;

typedef __bf16 bf16x2_t __attribute__((ext_vector_type(2)));
__device__ __forceinline__ unsigned cvt_pk_bf16(float lo, float hi) { f32x2 v = {lo, hi}; bf16x2_t b = __builtin_convertvector(v, bf16x2_t); return __builtin_bit_cast(unsigned, b); }
__device__ __forceinline__ float bf2f(bf16_t b) { return __uint_as_float(((unsigned)b) << 16); }
__device__ __forceinline__ float bflo(unsigned w) { return __uint_as_float(w << 16); }
__device__ __forceinline__ float bfhi(unsigned w) { return __uint_as_float(w & 0xffff0000u); }
__device__ __forceinline__ float wave_sum(float v) {
#pragma unroll
    for (int o = 1; o < 64; o <<= 1) v += __shfl_xor(v, o);
    return v;
}
__device__ __forceinline__ float fast_exp2(float x) { return __builtin_amdgcn_exp2f(x); }
__device__ __forceinline__ float fast_rcp(float x) { return __builtin_amdgcn_rcpf(x); }
__device__ __forceinline__ float sigmoidf_(float x) { return fast_rcp(1.0f + fast_exp2(-1.4426950408889634f * x)); }
__device__ __forceinline__ float log2gamma(int h) { return __log2f(1.0f - exp2f(-5.0f - (float)h)); }
#define LDS_WAIT() asm volatile("s_waitcnt lgkmcnt(0)" ::: "memory")
#define VM_WAIT() asm volatile("s_waitcnt vmcnt(0)" ::: "memory")
#define SBAR() __builtin_amdgcn_sched_barrier(0)

#define XB_TMO      128
#define XB_XCNT(j)  (256  + 64 * (j))
#define XB_XSUB(j)  (1280 + 64 * (j))
#define XB_XGEN(j)  (2304 + 64 * (j))
#define XB_TOP      3328
#define XB_TOPGEN   3392
#define XCD_BAR_WORDS 3456
#define XB_SPIN_CAP (1u << 18)
__device__ __forceinline__ unsigned xb_ld(unsigned* p)              { return __hip_atomic_load(p, __ATOMIC_RELAXED, __HIP_MEMORY_SCOPE_AGENT); }
__device__ __forceinline__ unsigned xb_add(unsigned* p, unsigned v) { return __hip_atomic_fetch_add(p, v, __ATOMIC_RELAXED, __HIP_MEMORY_SCOPE_AGENT); }
__device__ __forceinline__ unsigned xb_xcc_id() { return (unsigned)__builtin_amdgcn_s_getreg((3 << 11) | 20) & 0xFu; }
#define XB_SPIN(cond, bar) do { unsigned _sp = 0; while (cond) { __builtin_amdgcn_s_sleep(1); \
    if ((++_sp & 255u) == 0u) { if (xb_ld(&(bar)[XB_TMO])) break; if (_sp > XB_SPIN_CAP) { atomicAdd(&(bar)[XB_TMO], 1u); break; } } } } while (0)
struct XcdBarrier { unsigned* bar; unsigned x; volatile LAS unsigned* st; };
__device__ __forceinline__ XcdBarrier xcd_barrier_post(unsigned* bar, volatile LAS unsigned* st) {
    XcdBarrier b; b.bar = bar; b.x = xb_xcc_id(); b.st = st;
    if (threadIdx.x == 0) (void)xb_add(&bar[XB_XCNT(b.x)], 1u);
    return b;
}
__device__ __forceinline__ void xcd_barrier_complete(unsigned* bar, unsigned x, unsigned& nloc, unsigned& nx) {
    const unsigned G = gridDim.x * gridDim.y * gridDim.z;
    unsigned sum, cnt, mine, sp = 0u;
    for (;;) {
        sum = 0u; cnt = 0u; mine = 0u;
#pragma unroll
        for (unsigned j = 0; j < 16; ++j) { const unsigned c = xb_ld(&bar[XB_XCNT(j)]); sum += c; cnt += (c > 0u) ? 1u : 0u; mine = (j == x) ? c : mine; }
        if (sum == G) break;
        __builtin_amdgcn_s_sleep(1);
        if ((++sp & 255u) == 0u) { if (xb_ld(&bar[XB_TMO])) break; if (sp > XB_SPIN_CAP) { atomicAdd(&bar[XB_TMO], 1u); break; } }
    }
    nloc = mine > 0u ? mine : 1u; nx = cnt > 0u ? cnt : 1u;
}
__device__ __forceinline__ void xcd_barrier(const XcdBarrier& b) {
    asm volatile("s_waitcnt vmcnt(0)" ::: "memory");
    __syncthreads();
    if (threadIdx.x == 0) {
        unsigned* bar = b.bar;
        __builtin_amdgcn_s_waitcnt(0);
        unsigned nloc = b.st[0], nx = b.st[1];
        if (nloc == 0u) { xcd_barrier_complete(bar, b.x, nloc, nx); b.st[0] = nloc; b.st[1] = nx; }
        const unsigned old = xb_add(&bar[XB_XSUB(b.x)], 1u);
        const unsigned gen = old / nloc;
        if (old + 1u == (gen + 1u) * nloc) {
            __builtin_amdgcn_fence(__ATOMIC_RELEASE, "agent");
            asm volatile("s_waitcnt vmcnt(0)" ::: "memory");
            const unsigned og = xb_add(&bar[XB_TOP], 1u);
            const unsigned tg = og / nx;
            if (og + 1u == (tg + 1u) * nx) xb_add(&bar[XB_TOPGEN], 1u);
            else XB_SPIN(xb_ld(&bar[XB_TOPGEN]) == tg, bar);
            __builtin_amdgcn_fence(__ATOMIC_ACQUIRE, "agent");
            xb_add(&bar[XB_XGEN(b.x)], 1u);
            asm volatile("s_waitcnt vmcnt(0)" ::: "memory");
        } else {
            XB_SPIN(xb_ld(&bar[XB_XGEN(b.x)]) == gen, bar);
            __builtin_amdgcn_fence(__ATOMIC_ACQUIRE, "agent");
            asm volatile("s_waitcnt vmcnt(0)" ::: "memory");
        }
    }
    __syncthreads();
}

namespace pg8 {
constexpr int BM = 256, BK = 64, HALF = 128, HTB = HALF * BK * 2, STAGE_BYTES = 8 * HTB, NXCD = 8, WGM = 8;
__host__ __device__ __forceinline__ int lds_byte(int r, int c) { const int st = (r >> 4) * 2 + (c >> 5), rr = r & 15, cc = c & 31, ob = rr * 64 + cc * 2; return st * 1024 + (ob ^ (((ob >> 9) & 1) << 5)); }
__host__ __device__ __forceinline__ void stage_rc(int b, int& R, int& C) { const int st = b / 1024, sb = b % 1024, swz = sb ^ (((sb >> 9) & 1) << 5); R = (st >> 1) * 16 + swz / 64; C = (st & 1) * 32 + (swz % 64) / 2; }

struct Unit { int pm, pn, seg; };
__device__ __forceinline__ bool tile_order(int L, int nM, int nN, int& pm, int& pn) {
    const int nwg = nM * nN; if (L >= nwg) return false;
    int wgid = L; { const int q = nwg / NXCD, r = nwg % NXCD, xcd = wgid % NXCD, off = wgid / NXCD; wgid = (xcd < r ? xcd * (q + 1) : r * (q + 1) + (xcd - r) * q) + off; }
    const int nig = WGM * nN, gid = wgid / nig, fm = gid * WGM, gsz = (nM - fm) < WGM ? (nM - fm) : WGM;
    pm = fm + ((wgid % nig) % gsz); pn = (wgid % nig) / gsz; return true;
}

template <class Epi, class Sched, bool ALIGN_EPI>
__device__ __forceinline__ void gemm_phase(LAS unsigned char* lds, const int lda, const int ldb, const int nt, const Sched& S, const Epi& E) {
    const int tid = threadIdx.x, wid = __builtin_amdgcn_readfirstlane(tid >> 6), lane = tid & 63, wr = wid >> 2, wc = wid & 3, fr = lane & 15, fq = lane >> 4;
    unsigned voffA[2], voffB[2];
#pragma unroll
    for (int i = 0; i < 2; ++i) { int R, C; stage_rc(tid * 16 + i * 8192, R, C); voffA[i] = (unsigned)(R * lda + C) * 2u; voffB[i] = (unsigned)(R * ldb + C) * 2u; }
    const size_t kstep = (size_t)(BK * 2);
    const size_t hstepA = (size_t)HALF * lda * 2, hstepB = (size_t)HALF * ldb * 2;
    const unsigned ldsw = (unsigned)wid * 1024u;
    const int aoff = lds_byte(wr * 64 + fr, fq * 8), boff = lds_byte(wc * 32 + fr, fq * 8);
#define PG8_SA(b, h) (((b) * 2 + (h)) * HTB)
#define PG8_SB(b, h) ((4 + (b) * 2 + (h)) * HTB)
#define PG8_STAGE(bufoff, gbase, voff) do { _Pragma("unroll") for (int _i = 0; _i < 2; ++_i) \
        __builtin_amdgcn_global_load_lds((const unsigned*)((const char*)(gbase) + (voff)[_i]), (LAS unsigned*)(lds + (bufoff) + ldsw + _i * 8192), 16, 0, 0); } while (0)
#define PG8_LDA(dst, b, h) do { _Pragma("unroll") for (int m = 0; m < 4; ++m) _Pragma("unroll") for (int k = 0; k < 2; ++k) dst[m][k] = *(const LAS bf16x8*)(lds + PG8_SA(b, h) + aoff + m * 2048 + k * 1024); } while (0)
#define PG8_LDB(dst, b, h) do { _Pragma("unroll") for (int n = 0; n < 2; ++n) _Pragma("unroll") for (int k = 0; k < 2; ++k) dst[n][k] = *(const LAS bf16x8*)(lds + PG8_SB(b, h) + boff + n * 2048 + k * 1024); } while (0)
#define PG8_MMA(ai, bj, At, Bt) do { __builtin_amdgcn_s_setprio(1); _Pragma("unroll") for (int m = 0; m < 4; ++m) _Pragma("unroll") for (int n = 0; n < 2; ++n) _Pragma("unroll") for (int k = 0; k < 2; ++k) \
        acc[ai][bj][m][n] = __builtin_amdgcn_mfma_f32_16x16x32_bf16(Bt[n][k], At[m][k], acc[ai][bj][m][n], 0, 0, 0); __builtin_amdgcn_s_setprio(0); } while (0)
#define PG8_WAIT_V(n) asm volatile("s_waitcnt vmcnt(" #n ")" ::: "memory")
#define PG8_WAIT_L(n) asm volatile("s_waitcnt lgkmcnt(" #n ")" ::: "memory")
#define PG8_BAR __builtin_amdgcn_s_barrier()
#define PG8_SCHED __builtin_amdgcn_sched_barrier(0)
    Unit cur, nxt; int ui = 0;
    if (!S.next(0, cur)) return;
    f32x4 acc[2][2][4][2];
#pragma unroll
    for (int a = 0; a < 2; ++a)
#pragma unroll
        for (int b = 0; b < 2; ++b)
#pragma unroll
            for (int m = 0; m < 4; ++m)
#pragma unroll
                for (int n = 0; n < 2; ++n) acc[a][b][m][n] = (f32x4){0.f, 0.f, 0.f, 0.f};
    bf16x8 At[4][2], B0[2][2], B1[2][2];
    const char* cA; const char* cB; S.bases(cur, cA, cB);
    PG8_STAGE(PG8_SB(0, 0), cB, voffB); PG8_STAGE(PG8_SB(0, 1), cB + hstepB, voffB); PG8_STAGE(PG8_SA(0, 0), cA, voffA); PG8_STAGE(PG8_SA(0, 1), cA + hstepA, voffA);
    if (wr == 1) PG8_BAR;
    PG8_WAIT_V(2); PG8_BAR;
    PG8_STAGE(PG8_SB(1, 0), cB + kstep, voffB); PG8_STAGE(PG8_SA(1, 0), cA + kstep, voffA); PG8_STAGE(PG8_SB(1, 1), cB + hstepB + kstep, voffB);
    PG8_WAIT_V(6); PG8_BAR;
    for (;;) {
        const bool has_next = S.next(ui + 1, nxt);
        const char* nA = cA; const char* nB = cB; if (has_next) S.bases(nxt, nA, nB);
        for (int t = 0; t < nt; t += 2) {
            const bool last = (t == nt - 2);
            const char* a1 = cA + (size_t)(t + 1) * kstep;
            const char* a2 = last ? nA : cA + (size_t)(t + 2) * kstep; const char* b2 = last ? nB : cB + (size_t)(t + 2) * kstep;
            const char* a3 = a2 + kstep; const char* b3 = b2 + kstep;
            PG8_LDB(B0, 0, 0); PG8_LDB(B1, 0, 1); PG8_SCHED; PG8_LDA(At, 0, 0); PG8_STAGE(PG8_SA(1, 1), a1 + hstepA, voffA);
            PG8_WAIT_V(8); PG8_WAIT_L(0); PG8_BAR; PG8_MMA(0, 0, At, B0); PG8_MMA(0, 1, At, B1); PG8_BAR; PG8_SCHED;
            PG8_LDA(At, 0, 1); PG8_STAGE(PG8_SB(0, 0), b2, voffB); PG8_STAGE(PG8_SB(0, 1), b2 + hstepB, voffB); PG8_STAGE(PG8_SA(0, 0), a2, voffA);
            PG8_WAIT_V(8); PG8_WAIT_L(0); PG8_BAR; PG8_MMA(1, 0, At, B0); PG8_MMA(1, 1, At, B1); PG8_BAR; PG8_SCHED;
            PG8_LDB(B0, 1, 0); PG8_LDB(B1, 1, 1); PG8_SCHED; PG8_LDA(At, 1, 0); PG8_STAGE(PG8_SA(0, 1), a2 + hstepA, voffA);
            PG8_WAIT_V(8); PG8_WAIT_L(0); PG8_BAR; PG8_MMA(0, 0, At, B0); PG8_MMA(0, 1, At, B1); PG8_BAR; PG8_SCHED;
            PG8_LDA(At, 1, 1); PG8_STAGE(PG8_SB(1, 0), b3, voffB); PG8_STAGE(PG8_SB(1, 1), b3 + hstepB, voffB); PG8_STAGE(PG8_SA(1, 0), a3, voffA);
            PG8_WAIT_V(8); PG8_WAIT_L(0); PG8_BAR; PG8_MMA(1, 0, At, B0); PG8_MMA(1, 1, At, B1); PG8_BAR; PG8_SCHED;
        }
        if constexpr (ALIGN_EPI) { if (wr == 0) PG8_BAR; }
        const bool zero = E(acc, cur, wr, wc, fr, fq);
        if (!has_next) break;
        if (zero) {
#pragma unroll
            for (int a = 0; a < 2; ++a)
#pragma unroll
                for (int b = 0; b < 2; ++b)
#pragma unroll
                    for (int m = 0; m < 4; ++m)
#pragma unroll
                        for (int n = 0; n < 2; ++n) acc[a][b][m][n] = (f32x4){0.f, 0.f, 0.f, 0.f};
        }
        cur = nxt; cA = nA; cB = nB; ++ui;
        if constexpr (ALIGN_EPI) { if (wr == 1) PG8_BAR; }
    }
    PG8_WAIT_V(0);
    if constexpr (!ALIGN_EPI) { if (wr == 0) PG8_BAR; }
    PG8_BAR;
#undef PG8_SA
#undef PG8_SB
#undef PG8_STAGE
#undef PG8_LDA
#undef PG8_LDB
#undef PG8_MMA
#undef PG8_WAIT_V
#undef PG8_WAIT_L
#undef PG8_BAR
#undef PG8_SCHED
}
}

#define F_TID ((int)threadIdx.x)
#define F_LANE ((int)threadIdx.x & 63)
#define F_WAVE (__builtin_amdgcn_readfirstlane((int)threadIdx.x >> 6))
struct Frame {
    LAS unsigned char* lds;
    int G, vcu;
    unsigned char* ws; float* out;
    const float* x; const int* pos; const float* g_mix; const float* w_in; const float* g_ret; const float* w_ret_o; const float* g_qa; const float* w_q_b;
    const float* g_kva; const float* w_kv_b; const float* w_mla_o; const float* w_out; const float* g_mlp; const float* w_up; const float* w_down; const float* g_f;
};
#define WSP(T_, off) ((T_*)(F.ws + (off)))

__device__ __forceinline__ int nat32(int c) { const int n = (c >> 4) & 1, fq = (c >> 2) & 3, e = c & 3; return (c & ~31) | (8 * fq + 4 * n + e); }
__device__ __forceinline__ int rope128(int c) { const int wc = (c >> 5) & 3, n = (c >> 4) & 1, fq = (c >> 2) & 3, e = c & 3; return (c & ~127) | (64 * n + 16 * wc + 4 * fq + e); }
__device__ __forceinline__ int rope64(int c) { const int wl = (c >> 5) & 1, n = (c >> 4) & 1, fq = (c >> 2) & 3, e = c & 3; return (c & ~63) | (32 * n + 16 * wl + 4 * fq + e); }
enum { MAP_NAT = 0, MAP_G1 = 1, MAP_Q = 2, MAP_KV = 3 };
template <int MAP> __device__ __forceinline__ int lcmap(int c) {
    if (MAP == MAP_NAT) return nat32(c);
    if (MAP == MAP_G1) {
        const int t = c >> 8;
        if (t < 4) return LO_RQ + rope128(c);
        if (t < 8) return LO_RK + rope128(c - 1024);
        if (t < 16) return LO_RV + nat32(c - 2048);
        if (t < 24) return LO_RG + nat32(c - 4096);
        if (t < 26) return LO_CQ + nat32(c - 6144);
        if (t < 28) return LO_CKV + nat32(c - 6656);
        if (t < 36) return LO_GRET + nat32(c - 7168);
        if (t < 44) return LO_GMLA + nat32(c - 9216);
        const int cc = c - 11264; return cc < 64 ? LO_KPE + rope64(cc) : -1;
    }
    if (MAP == MAP_Q) {
        if (c < 2048) { const int l = nat32(c); return (l >> 7) * 192 + (l & 127); }
        const int cc = c - 2048, l = rope64(cc); return (l >> 6) * 192 + 128 + (l & 63);
    }
    { const int part = c >> 11, l = nat32(c & 2047); return (l >> 7) * 256 + part * 128 + (l & 127); }
}
template <int MAP>
__device__ __forceinline__ void cvt_item(const float* W, int Nsrc, bf16_t* Wt, int ldw, int koff, int nblk, const float* gain, LAS float* scr, int item, int lane) {
    const int kb = item / nblk, nb = item % nblk, k0 = 64 * kb, n0 = 32 * nb;
    const int lc = lcmap<MAP>(n0 + (lane & 31));
#pragma unroll 8
    for (int i = 0; i < 32; ++i) { const int kk = 2 * i + (lane >> 5); float v = 0.f; if (lc >= 0) { v = W[(size_t)(k0 + kk) * Nsrc + lc]; if (gain) v *= gain[k0 + kk]; } scr[kk * 33 + (lane & 31)] = v; }
    LDS_WAIT(); asm volatile("" ::: "memory");
    const int c = lane & 7;
#pragma unroll
    for (int j = 0; j < 4; ++j) { const int n = (lane >> 3) + 8 * j; const LAS float* s = scr + (8 * c) * 33 + n;
        u32x4 o; o.x = cvt_pk_bf16(s[0 * 33], s[1 * 33]); o.y = cvt_pk_bf16(s[2 * 33], s[3 * 33]); o.z = cvt_pk_bf16(s[4 * 33], s[5 * 33]); o.w = cvt_pk_bf16(s[6 * 33], s[7 * 33]);
        *(u32x4*)(Wt + (size_t)(n0 + n) * ldw + koff + k0 + 8 * c) = o; }
    LDS_WAIT(); asm volatile("" ::: "memory");
}
__device__ __forceinline__ void sincos_acc(float ang, float& s, float& c) {
    const double a = (double)ang; const double k = rint(a * 0.63661977236758134308);
    const double r = fma(-k, 1.57079632679489661923, a) - k * 6.123233995736766e-17;
    const double r2 = r * r;
    const double sp = r * (1.0 + r2 * (-1.0 / 6 + r2 * (1.0 / 120 + r2 * (-1.0 / 5040 + r2 * (1.0 / 362880 + r2 * (-1.0 / 39916800))))));
    const double cp = 1.0 + r2 * (-0.5 + r2 * (1.0 / 24 + r2 * (-1.0 / 720 + r2 * (1.0 / 40320 + r2 * (-1.0 / 3628800 + r2 * (1.0 / 479001600))))));
    const int q = ((int)k) & 3;
    const double ss = (q & 1) ? cp : sp, cc = (q & 1) ? sp : cp;
    s = (float)((q & 2) ? -ss : ss); c = (float)(((q + 1) & 2) ? -cc : cc);
}
__device__ __forceinline__ void p0_prologue(Frame& F) {
    LAS float* scr = (LAS float*)(F.lds + F_WAVE * 16384);
    const int gw = F.vcu * 8 + F_WAVE, NGW = F.G * 8;
    constexpr int I_WI = 32 * (N1P / 32), I_WQ = 8 * 96, I_WKV = 8 * 128, I_WR = 32 * 64, I_WM = 32 * 64, I_WO = 32 * 64;
    constexpr int NITEMS = I_WI + I_WQ + I_WKV + I_WR + I_WM + I_WO;
    for (int it = gw; it < NITEMS; it += NGW) {
        int r = it;
        if (r < I_WI) { cvt_item<MAP_G1>(F.w_in, N_IN, WSP(bf16_t, WS_WI), 2048, 0, N1P / 32, nullptr, scr, r, F_LANE); continue; } r -= I_WI;
        if (r < I_WQ) { cvt_item<MAP_Q>(F.w_q_b, 3072, WSP(bf16_t, WS_WQ), 512, 0, 96, F.g_qa, scr, r, F_LANE); continue; } r -= I_WQ;
        if (r < I_WKV) { cvt_item<MAP_KV>(F.w_kv_b, 4096, WSP(bf16_t, WS_WKV), 512, 0, 128, F.g_kva, scr, r, F_LANE); continue; } r -= I_WKV;
        if (r < I_WR) { cvt_item<MAP_NAT>(F.w_ret_o, 2048, WSP(bf16_t, WS_WRM), 4096, 0, 64, nullptr, scr, r, F_LANE); continue; } r -= I_WR;
        if (r < I_WM) { cvt_item<MAP_NAT>(F.w_mla_o, 2048, WSP(bf16_t, WS_WRM), 4096, 2048, 64, nullptr, scr, r, F_LANE); continue; } r -= I_WM;
        cvt_item<MAP_NAT>(F.w_out, 2048, WSP(bf16_t, WS_WO), 2048, 0, 64, nullptr, scr, r, F_LANE);
    }
    bf16_t* U = WSP(bf16_t, WS_U);
    for (int m = gw; m < T; m += NGW) {
        const f32x4* xr = (const f32x4*)(F.x + (size_t)m * DM) + F_LANE; const f32x4* gr = (const f32x4*)F.g_mix + F_LANE;
        f32x4 v[8]; float s = 0.f;
#pragma unroll
        for (int j = 0; j < 8; ++j) { v[j] = xr[64 * j]; s += (v[j].x * v[j].x + v[j].y * v[j].y) + (v[j].z * v[j].z + v[j].w * v[j].w); }
        const float rinv = 1.0f / sqrtf(wave_sum(s) * (1.f / DM) + EPS);
        u32x2* o8 = (u32x2*)(U + (size_t)m * DM) + F_LANE;
#pragma unroll
        for (int j = 0; j < 8; ++j) { const f32x4 g = gr[64 * j]; u32x2 w; w.x = cvt_pk_bf16(v[j].x * rinv * g.x, v[j].y * rinv * g.y); w.y = cvt_pk_bf16(v[j].z * rinv * g.z, v[j].w * rinv * g.w); o8[64 * j] = w; }
    }
    float* rc64 = WSP(float, WS_RC64); float* rs64 = WSP(float, WS_RS64); float* rc32 = WSP(float, WS_RC32); float* rs32 = WSP(float, WS_RS32);
    const int gt = (F.vcu * 8 + F_WAVE) * 64 + F_LANE, NGT = F.G * 512;
    for (int i = gt; i < T * 64; i += NGT) { const int t = i >> 6, j = i & 63; const float inv = powf(10000.0f, -(float)j / 64.0f); const float ang = (float)F.pos[t] * inv; float s, c; sincos_acc(ang, s, c); rc64[i] = c; rs64[i] = s; }
    for (int i = gt; i < T * 32; i += NGT) { const int t = i >> 5, j = i & 31; const float inv = powf(10000.0f, -(float)j / 32.0f); const float ang = (float)F.pos[t] * inv; float s, c; sincos_acc(ang, s, c); rc32[i] = c; rs32[i] = s; }
}
__device__ __forceinline__ void p5_convert(Frame& F) {
    LAS float* scr = (LAS float*)(F.lds + F_WAVE * 16384);
    const int gw = F.vcu * 8 + F_WAVE, NGW = F.G * 8;
    constexpr int I_WU = 32 * 256, I_WD = 128 * 64;
    for (int it = gw; it < I_WU + I_WD; it += NGW) {
        if (it < I_WU) cvt_item<MAP_NAT>(F.w_up, 8192, WSP(bf16_t, WS_WU), 2048, 0, 256, F.g_mlp, scr, it, F_LANE);
        else cvt_item<MAP_NAT>(F.w_down, 2048, WSP(bf16_t, WS_WD), 8192, 0, 64, nullptr, scr, it - I_WU, F_LANE);
    }
}

typedef f32x4 Acc[2][2][4][2];
__device__ __forceinline__ u32x4 pack8(f32x4 a, f32x4 b) { u32x4 w; w.x = cvt_pk_bf16(a[0], a[1]); w.y = cvt_pk_bf16(a[2], a[3]); w.z = cvt_pk_bf16(b[0], b[1]); w.w = cvt_pk_bf16(b[2], b[3]); return w; }
template <int OP> __device__ __forceinline__ f32x4 act4(f32x4 v) {
    if (OP == 1) { f32x4 o; for (int i = 0; i < 4; ++i) o[i] = v[i] * sigmoidf_(v[i]); return o; }
    if (OP == 2) { f32x4 o; for (int i = 0; i < 4; ++i) o[i] = sigmoidf_(v[i]); return o; }
    if (OP == 3) { f32x4 o; for (int i = 0; i < 4; ++i) { const float r = fmaxf(v[i], 0.f); o[i] = r * r; } return o; }
    return v;
}
template <int OP, bool ROWSCALE>
__device__ __forceinline__ void store_tile_bf16(const Acc& acc, bf16_t* O, int ldc, int row0, int col0, const float* rs, float cs) {
#pragma unroll
    for (int ai = 0; ai < 2; ++ai)
#pragma unroll
        for (int m = 0; m < 4; ++m) { const int row = row0 + ai * 128 + m * 16; bf16_t* rowp = O + (size_t)row * ldc + col0; float sc = cs; if (ROWSCALE) sc *= rs[row];
#pragma unroll
            for (int bj = 0; bj < 2; ++bj) { const f32x4 v0 = act4<OP>(acc[ai][bj][m][0] * sc), v1 = act4<OP>(acc[ai][bj][m][1] * sc); *(u32x4*)(rowp + bj * 128) = pack8(v0, v1); } }
}
__device__ __forceinline__ void ssq_tile(const Acc& acc, float* ssq, int row0, int fq) {
#pragma unroll
    for (int ai = 0; ai < 2; ++ai)
#pragma unroll
        for (int m = 0; m < 4; ++m) { float s = 0.f;
#pragma unroll
            for (int bj = 0; bj < 2; ++bj)
#pragma unroll
                for (int n = 0; n < 2; ++n) { const f32x4 v = acc[ai][bj][m][n]; s += (v[0] * v[0] + v[1] * v[1]) + (v[2] * v[2] + v[3] * v[3]); }
            s += __shfl_xor(s, 16); s += __shfl_xor(s, 32);
            if (fq == 0) atomicAdd(ssq + row0 + ai * 128 + m * 16, s); }
}

struct SchedG1 {
    int G, c; const char* A; const char* B;
    __device__ __forceinline__ bool next(int i, pg8::Unit& u) const { u.seg = 0; return pg8::tile_order(i * G + c, T / 256, N1P / 256, u.pm, u.pn); }
    __device__ __forceinline__ void bases(const pg8::Unit& u, const char*& cA, const char*& cB) const { cA = A + (size_t)u.pm * 256 * 2048 * 2; cB = B + (size_t)u.pn * 256 * 2048 * 2; }
};
struct EpiG1 {
    bf16_t *RQ, *RK, *RV, *SG, *CQ, *CKV, *KPE, *SGR, *SGM; const float *rc64, *rs64, *rc32, *rs32; float *ssq_q, *ssq_kv;
    __device__ __forceinline__ bool operator()(const Acc& acc, const pg8::Unit& u, int wr, int wc, int fr, int fq) const {
        const int pn = u.pn, row0 = u.pm * 256 + wr * 64 + fr, cl = wc * 32 + 8 * fq;
        if (pn < 8) {
            bf16_t* O = pn < 4 ? RQ : RK; const float sc = pn < 4 ? 1.0f : RK_SCALE;
#pragma unroll
            for (int ai = 0; ai < 2; ++ai)
#pragma unroll
                for (int m = 0; m < 4; ++m) { const int row = row0 + ai * 128 + m * 16;
                    const f32x4 c = *(const f32x4*)(rc64 + (size_t)row * 64 + 16 * wc + 4 * fq) * sc, s = *(const f32x4*)(rs64 + (size_t)row * 64 + 16 * wc + 4 * fq) * sc;
#pragma unroll
                    for (int bj = 0; bj < 2; ++bj) { const f32x4 x1 = acc[ai][bj][m][0], x2 = acc[ai][bj][m][1];
                        *(u32x4*)(O + (size_t)row * 1024 + ((pn & 3) * 2 + bj) * 128 + cl) = pack8(x1 * c - x2 * s, x2 * c + x1 * s); } }
        } else if (pn < 16) store_tile_bf16<0, false>(acc, RV, 2048, row0, (pn - 8) * 256 + cl, nullptr, 1.f);
        else if (pn < 24) store_tile_bf16<1, false>(acc, SG, 2048, row0, (pn - 16) * 256 + cl, nullptr, 1.f);
        else if (pn < 26) { store_tile_bf16<0, false>(acc, CQ, 512, row0, (pn - 24) * 256 + cl, nullptr, 1.f); if (!NO_SSQ_TEST) ssq_tile(acc, ssq_q, row0, fq); }
        else if (pn < 28) { store_tile_bf16<0, false>(acc, CKV, 512, row0, (pn - 26) * 256 + cl, nullptr, 1.f); if (!NO_SSQ_TEST) ssq_tile(acc, ssq_kv, row0, fq); }
        else if (pn < 36) store_tile_bf16<2, false>(acc, SGR, 2048, row0, (pn - 28) * 256 + cl, nullptr, 1.f);
        else if (pn < 44) store_tile_bf16<2, false>(acc, SGM, 2048, row0, (pn - 36) * 256 + cl, nullptr, 1.f);
        else if (wc < 2) {
#pragma unroll
            for (int ai = 0; ai < 2; ++ai)
#pragma unroll
                for (int m = 0; m < 4; ++m) { const int row = row0 + ai * 128 + m * 16;
                    const f32x4 c = *(const f32x4*)(rc32 + (size_t)row * 32 + 16 * wc + 4 * fq), s = *(const f32x4*)(rs32 + (size_t)row * 32 + 16 * wc + 4 * fq);
                    const f32x4 x1 = acc[ai][0][m][0], x2 = acc[ai][0][m][1];
                    *(u32x4*)(KPE + (size_t)row * 64 + cl) = pack8(x1 * c - x2 * s, x2 * c + x1 * s); }
        }
        return true;
    }
};
struct SchedG2 {
    int G, c; const char *CQ, *CKV, *WQ, *WKV;
    __device__ __forceinline__ bool next(int i, pg8::Unit& u) const { u.seg = 0; return pg8::tile_order(i * G + c, T / 256, 28, u.pm, u.pn); }
    __device__ __forceinline__ void bases(const pg8::Unit& u, const char*& cA, const char*& cB) const {
        const bool q = u.pn < 12; cA = (q ? CQ : CKV) + (size_t)u.pm * 256 * 512 * 2; cB = q ? WQ + (size_t)u.pn * 256 * 512 * 2 : WKV + (size_t)(u.pn - 12) * 256 * 512 * 2; }
};
struct EpiG2 {
    bf16_t *QN, *QP, *KN, *V; const float *rc32, *rs32; const float *ssq_q, *ssq_kv;
    __device__ __forceinline__ bool operator()(const Acc& acc, const pg8::Unit& u, int wr, int wc, int fr, int fq) const {
        const int pn = u.pn, row0 = u.pm * 256 + wr * 64 + fr, cl = wc * 32 + 8 * fq;
        const float* ssq = pn < 12 ? ssq_q : ssq_kv; const float cs = pn < 12 ? C2Q : 1.0f;
        float rinv[2][4];
#pragma unroll
        for (int ai = 0; ai < 2; ++ai)
#pragma unroll
            for (int m = 0; m < 4; ++m) rinv[ai][m] = cs / sqrtf(__builtin_nontemporal_load(ssq + row0 + ai * 128 + m * 16) * (1.0f / 512.0f) + EPS);
        bf16_t* O; int colt;
        if (pn < 8) { O = QN; colt = pn * 256; } else if (pn < 12) { O = QP; colt = (pn - 8) * 256; } else if (pn < 20) { O = KN; colt = (pn - 12) * 256; } else { O = V; colt = (pn - 20) * 256; }
        const int ldc = (pn >= 8 && pn < 12) ? 1024 : 2048;
        const bool rope = (pn >= 8 && pn < 12);
#pragma unroll
        for (int ai = 0; ai < 2; ++ai)
#pragma unroll
            for (int m = 0; m < 4; ++m) { const int row = row0 + ai * 128 + m * 16; const float sc = rinv[ai][m];
                f32x4 c = (f32x4){sc, sc, sc, sc}, s = (f32x4){0.f, 0.f, 0.f, 0.f};
                if (rope) { c = *(const f32x4*)(rc32 + (size_t)row * 32 + 16 * (wc & 1) + 4 * fq) * sc; s = *(const f32x4*)(rs32 + (size_t)row * 32 + 16 * (wc & 1) + 4 * fq) * sc; }
#pragma unroll
                for (int bj = 0; bj < 2; ++bj) { const f32x4 x1 = acc[ai][bj][m][0], x2 = acc[ai][bj][m][1];
                    *(u32x4*)(O + (size_t)row * ldc + colt + bj * 128 + cl) = pack8(x1 * c - x2 * s, x2 * c + x1 * s); } }
        return true;
    }
};
struct SchedG5 {
    int G, c; const char *A, *B;
    __device__ __forceinline__ bool next(int i, pg8::Unit& u) const { u.seg = i & 1; return pg8::tile_order((i >> 1) * G + c, T / 256, 8, u.pm, u.pn); }
    __device__ __forceinline__ void bases(const pg8::Unit& u, const char*& cA, const char*& cB) const { cA = A + ((size_t)u.pm * 256 * 4096 + u.seg * 2048) * 2; cB = B + ((size_t)u.pn * 256 * 4096 + u.seg * 2048) * 2; }
};
struct EpiG5 {
    const bf16_t *SGR, *SGM; bf16_t* MERGED;
    __device__ __forceinline__ bool operator()(Acc& acc, const pg8::Unit& u, int wr, int wc, int fr, int fq) const {
        const int row0 = u.pm * 256 + wr * 64 + fr, col0 = u.pn * 256 + wc * 32 + 8 * fq;
#pragma unroll
        for (int ai = 0; ai < 2; ++ai)
#pragma unroll
            for (int m = 0; m < 4; ++m) { const size_t off = (size_t)(row0 + ai * 128 + m * 16) * 2048 + col0;
#pragma unroll
                for (int bj = 0; bj < 2; ++bj) {
                    const u32x4 gm = *(const u32x4*)(SGM + off + bj * 128);
                    const f32x4 m0 = (f32x4){bflo(gm.x), bfhi(gm.x), bflo(gm.y), bfhi(gm.y)}, m1 = (f32x4){bflo(gm.z), bfhi(gm.z), bflo(gm.w), bfhi(gm.w)};
                    if (u.seg == 0) {
                        const u32x4 gr = *(const u32x4*)(SGR + off + bj * 128);
                        const f32x4 r0 = (f32x4){bflo(gr.x), bfhi(gr.x), bflo(gr.y), bfhi(gr.y)}, r1 = (f32x4){bflo(gr.z), bfhi(gr.z), bflo(gr.w), bfhi(gr.w)};
#pragma unroll
                        for (int e = 0; e < 4; ++e) { acc[ai][bj][m][0][e] *= r0[e] * fast_rcp(fmaxf(m0[e], 1e-30f)); acc[ai][bj][m][1][e] *= r1[e] * fast_rcp(fmaxf(m1[e], 1e-30f)); }
                    } else *(u32x4*)(MERGED + off + bj * 128) = pack8(acc[ai][bj][m][0] * m0, acc[ai][bj][m][1] * m1);
                } }
        return u.seg != 0;
    }
};
struct SchedN {
    int G, c, nN; const char *A, *B; size_t astep, bstep;
    __device__ __forceinline__ bool next(int i, pg8::Unit& u) const { u.seg = 0; return pg8::tile_order(i * G + c, T / 256, nN, u.pm, u.pn); }
    __device__ __forceinline__ void bases(const pg8::Unit& u, const char*& cA, const char*& cB) const { cA = A + (size_t)u.pm * astep; cB = B + (size_t)u.pn * bstep; }
};
struct EpiG6 {
    const float* x; float* h1; bf16_t* H1B; float* ssq;
    __device__ __forceinline__ bool operator()(const Acc& acc, const pg8::Unit& u, int wr, int wc, int fr, int fq) const {
        const int row0 = u.pm * 256 + wr * 64 + fr, col0 = u.pn * 256 + wc * 32 + 8 * fq;
#pragma unroll
        for (int ai = 0; ai < 2; ++ai)
#pragma unroll
            for (int m = 0; m < 4; ++m) { const int row = row0 + ai * 128 + m * 16; const size_t off = (size_t)row * 2048 + col0; float s = 0.f;
#pragma unroll
                for (int bj = 0; bj < 2; ++bj) {
                    const f32x4 a = *(const f32x4*)(x + off + bj * 128) + acc[ai][bj][m][0], b = *(const f32x4*)(x + off + bj * 128 + 4) + acc[ai][bj][m][1];
                    *(f32x4*)(h1 + off + bj * 128) = a; *(f32x4*)(h1 + off + bj * 128 + 4) = b; *(u32x4*)(H1B + off + bj * 128) = pack8(a, b);
                    s += (a[0] * a[0] + a[1] * a[1]) + (a[2] * a[2] + a[3] * a[3]) + (b[0] * b[0] + b[1] * b[1]) + (b[2] * b[2] + b[3] * b[3]); }
                s += __shfl_xor(s, 16); s += __shfl_xor(s, 32);
                if (fq == 0) atomicAdd(ssq + row, s); }
        return true;
    }
};
struct EpiG7 {
    bf16_t* HMID; const float* ssq;
    __device__ __forceinline__ bool operator()(const Acc& acc, const pg8::Unit& u, int wr, int wc, int fr, int fq) const {
        const int row0 = u.pm * 256 + wr * 64 + fr, col0 = u.pn * 256 + wc * 32 + 8 * fq;
#pragma unroll
        for (int ai = 0; ai < 2; ++ai)
#pragma unroll
            for (int m = 0; m < 4; ++m) { const int row = row0 + ai * 128 + m * 16; const float sc = 1.0f / sqrtf(__builtin_nontemporal_load(ssq + row) * (1.0f / 2048.0f) + EPS);
#pragma unroll
                for (int bj = 0; bj < 2; ++bj) *(u32x4*)(HMID + (size_t)row * 8192 + col0 + bj * 128) = pack8(act4<3>(acc[ai][bj][m][0] * sc), act4<3>(acc[ai][bj][m][1] * sc)); }
        return true;
    }
};
struct EpiG8 {
    float* h; float* ssq;
    __device__ __forceinline__ bool operator()(const Acc& acc, const pg8::Unit& u, int wr, int wc, int fr, int fq) const {
        const int row0 = u.pm * 256 + wr * 64 + fr, col0 = u.pn * 256 + wc * 32 + 8 * fq;
#pragma unroll
        for (int ai = 0; ai < 2; ++ai)
#pragma unroll
            for (int m = 0; m < 4; ++m) { const int row = row0 + ai * 128 + m * 16; const size_t off = (size_t)row * 2048 + col0; float s = 0.f;
#pragma unroll
                for (int bj = 0; bj < 2; ++bj) {
                    const f32x4 a = *(const f32x4*)(h + off + bj * 128) + acc[ai][bj][m][0], b = *(const f32x4*)(h + off + bj * 128 + 4) + acc[ai][bj][m][1];
                    *(f32x4*)(h + off + bj * 128) = a; *(f32x4*)(h + off + bj * 128 + 4) = b;
                    s += (a[0] * a[0] + a[1] * a[1]) + (a[2] * a[2] + a[3] * a[3]) + (b[0] * b[0] + b[1] * b[1]) + (b[2] * b[2] + b[3] * b[3]); }
                s += __shfl_xor(s, 16); s += __shfl_xor(s, 32);
                if (fq == 0) atomicAdd(ssq + row, s); }
        return true;
    }
};

__device__ __forceinline__ int crow(int r, int hi) { return (r & 3) + 8 * (r >> 2) + 4 * hi; }
#define KSWZ(row, colB) ((row) * 256 + ((colB) ^ (((row) & 7) << 4)))
#define PSWZ(row, colB) ((row) * 128 + ((colB) ^ ((((row) >> 1) & 7) << 4)))
template <int NCB> __device__ __forceinline__ int v_st(int k, int c) { const int kk = (k & ~0xC) | ((k & 4) << 1) | ((k & 8) >> 1); return ((kk >> 3) * NCB + (c >> 5)) * 512 + ((kk & 7) * 32 + (c & 31)) * 2; }
__device__ __forceinline__ int v_rd_base(int lane) { return ((lane & 3) << 3) | (((lane >> 2) & 3) << 6) | (((lane >> 4) & 1) << 5) | (((lane >> 5) & 1) << 8); }
template <int NCB> constexpr int v_rd_off(int d0, int ks, int half) { return d0 * 512 + ks * (2 * NCB * 512) + half * (NCB * 512); }
template <int OFF> __device__ __forceinline__ s16x4 tr_read(int vb) { s16x4 r; asm volatile("ds_read_b64_tr_b16 %0, %1 offset:%2" : "=&v"(r) : "v"(vb), "i"(OFF) : "memory"); return r; }
#define PKF(L, H) (bf16x8){L[0], L[1], L[2], L[3], H[0], H[1], H[2], H[3]}
template <int NCB, int D0, int KS> __device__ __forceinline__ void tr_frag_issue(int vb, s16x4& lo, s16x4& hi) { lo = tr_read<v_rd_off<NCB>(D0, KS, 0)>(vb); hi = tr_read<v_rd_off<NCB>(D0, KS, 1)>(vb); }
__device__ __forceinline__ void p_to_frags(const f32x16& p0, const f32x16& p1, bf16x8& pa0, bf16x8& pa1, bf16x8& pa2, bf16x8& pa3) {
#define PK4(P, BASE, OUT) do { unsigned a0 = cvt_pk_bf16(P[BASE + 0], P[BASE + 1]), a1 = cvt_pk_bf16(P[BASE + 2], P[BASE + 3]);   \
    unsigned b0 = cvt_pk_bf16(P[BASE + 4], P[BASE + 5]), b1 = cvt_pk_bf16(P[BASE + 6], P[BASE + 7]);                              \
    auto r0 = __builtin_amdgcn_permlane32_swap(a0, b0, false, false); auto r1 = __builtin_amdgcn_permlane32_swap(a1, b1, false, false); \
    u32x4 w = {r0[0], r1[0], r0[1], r1[1]}; OUT = *reinterpret_cast<bf16x8*>(&w); } while (0)
    PK4(p0, 0, pa0); PK4(p0, 8, pa1); PK4(p1, 0, pa2); PK4(p1, 8, pa3);
#undef PK4
}
template <int NCB, int D0> __device__ __forceinline__ void pv_one(f32x16& od, int vb, bf16x8 pa0, bf16x8 pa1, bf16x8 pa2, bf16x8 pa3) {
    s16x4 l0, h0, l1, h1, l2, h2, l3, h3;
    tr_frag_issue<NCB, D0, 0>(vb, l0, h0); tr_frag_issue<NCB, D0, 1>(vb, l1, h1); tr_frag_issue<NCB, D0, 2>(vb, l2, h2); tr_frag_issue<NCB, D0, 3>(vb, l3, h3);
    asm volatile("s_waitcnt lgkmcnt(0)" ::: "memory"); SBAR();
    od = __builtin_amdgcn_mfma_f32_32x32x16_bf16(pa0, PKF(l0, h0), od, 0, 0, 0);
    od = __builtin_amdgcn_mfma_f32_32x32x16_bf16(pa1, PKF(l1, h1), od, 0, 0, 0);
    od = __builtin_amdgcn_mfma_f32_32x32x16_bf16(pa2, PKF(l2, h2), od, 0, 0, 0);
    od = __builtin_amdgcn_mfma_f32_32x32x16_bf16(pa3, PKF(l3, h3), od, 0, 0, 0);
}
__device__ __forceinline__ float half_sum32(float v) {
#pragma unroll
    for (int o = 1; o < 32; o <<= 1) v += __shfl_xor(v, o);
    return v;
}

__device__ __forceinline__ void ret_local_unit(Frame& F, int unit) {
    const int tid = F_TID, lane = F_LANE, w = F_WAVE, r32 = lane & 31, hi = lane >> 5;
    const int bh = unit >> 4, sc = unit & 15, b = bh >> 3, h = bh & 7; const int t0 = b * SEQ + sc * 256;
    const bf16_t* RK = WSP(bf16_t, WS_RK); const bf16_t* RV = WSP(bf16_t, WS_RV); float* KVL = WSP(float, WS_KVL) + (size_t)unit * 32768;
    const float lg = log2gamma(h);
    char* lds = (char*)F.lds; const int lbase = (int)(uintptr_t)F.lds;
    f32x16 acc[4];
#pragma unroll
    for (int i = 0; i < 4; ++i) acc[i] = f32x16{};
    const int kvb = lbase + v_rd_base(lane), vvb = lbase + 16384 + v_rd_base(lane);
    for (int tt = 0; tt < 4; ++tt) {
#pragma unroll
        for (int i = 0; i < 2; ++i) { const int key = (tid >> 4) + 32 * i, c8 = (tid & 15) * 8; const int p = tt * 64 + key;
            const u32x4 kr = *(const u32x4*)(RK + (size_t)(t0 + p) * 1024 + h * 128 + c8); const float g = fast_exp2(lg * (float)(255 - p));
            u32x4 o; o.x = cvt_pk_bf16(bflo(kr.x) * g, bfhi(kr.x) * g); o.y = cvt_pk_bf16(bflo(kr.y) * g, bfhi(kr.y) * g); o.z = cvt_pk_bf16(bflo(kr.z) * g, bfhi(kr.z) * g); o.w = cvt_pk_bf16(bflo(kr.w) * g, bfhi(kr.w) * g);
            *(u32x4*)(lds + v_st<4>(key, c8)) = o; }
#pragma unroll
        for (int i = 0; i < 4; ++i) { const int key = (tid >> 5) + 16 * i, c8 = (tid & 31) * 8;
            *(u32x4*)(lds + 16384 + v_st<8>(key, c8)) = *(const u32x4*)(RV + (size_t)(t0 + tt * 64 + key) * 2048 + h * 256 + c8); }
        __syncthreads();
#define RL_STEP(KS) do { s16x4 bl, bh_, a0l, a0h, a1l, a1h, a2l, a2h, a3l, a3h; \
        tr_frag_issue<8, 0, KS>(vvb + w * 512, bl, bh_); \
        tr_frag_issue<4, 0, KS>(kvb, a0l, a0h); tr_frag_issue<4, 1, KS>(kvb, a1l, a1h); tr_frag_issue<4, 2, KS>(kvb, a2l, a2h); tr_frag_issue<4, 3, KS>(kvb, a3l, a3h); \
        asm volatile("s_waitcnt lgkmcnt(0)" ::: "memory"); SBAR(); \
        const bf16x8 bf = PKF(bl, bh_); \
        acc[0] = __builtin_amdgcn_mfma_f32_32x32x16_bf16(PKF(a0l, a0h), bf, acc[0], 0, 0, 0); acc[1] = __builtin_amdgcn_mfma_f32_32x32x16_bf16(PKF(a1l, a1h), bf, acc[1], 0, 0, 0); \
        acc[2] = __builtin_amdgcn_mfma_f32_32x32x16_bf16(PKF(a2l, a2h), bf, acc[2], 0, 0, 0); acc[3] = __builtin_amdgcn_mfma_f32_32x32x16_bf16(PKF(a3l, a3h), bf, acc[3], 0, 0, 0); } while (0)
        RL_STEP(0); RL_STEP(1); RL_STEP(2); RL_STEP(3);
#undef RL_STEP
        __syncthreads();
    }
#pragma unroll
    for (int db = 0; db < 4; ++db)
#pragma unroll
        for (int r = 0; r < 16; ++r) KVL[(size_t)(32 * db + crow(r, hi)) * 256 + 32 * w + r32] = acc[db][r];
}
__device__ __forceinline__ void ret_scan(Frame& F) {
    const int gt = (F.vcu * 8 + F_WAVE) * 64 + F_LANE;
    if (gt >= 16 * 128 * 64) return;
    const int bh = gt >> 13, rem = gt & 8191, dk = rem >> 6, c4 = (rem & 63) * 4; const int h = bh & 7;
    const float g256 = fast_exp2(log2gamma(h) * 256.0f);
    const float* KVL = WSP(float, WS_KVL) + (size_t)bh * 16 * 32768 + dk * 256 + c4; bf16_t* S = WSP(bf16_t, WS_S) + (size_t)bh * 16 * 32768;
    const int so = v_st<8>(dk, c4) / 2;
    f32x4 st = (f32x4){0.f, 0.f, 0.f, 0.f};
    f32x4 nx = *(const f32x4*)(KVL);
    for (int sc = 0; sc < 15; ++sc) {
        const f32x4 cur = nx; if (sc < 14) nx = *(const f32x4*)(KVL + (size_t)(sc + 1) * 32768);
        st = st * g256 + cur;
        u32x2 w; w.x = cvt_pk_bf16(st[0], st[1]); w.y = cvt_pk_bf16(st[2], st[3]);
        *(u32x2*)(S + (size_t)(sc + 1) * 32768 + so) = w;
    }
}
__device__ __forceinline__ void ret_out_unit(Frame& F, int unit) {
    const int tid = F_TID, lane = F_LANE, w = F_WAVE, r32 = lane & 31, hi = lane >> 5;
    const int bh = unit >> 4, sc = unit & 15, b = bh >> 3, h = bh & 7; const int t0 = b * SEQ + sc * 256;
    const bf16_t* RQ = WSP(bf16_t, WS_RQ); const bf16_t* RK = WSP(bf16_t, WS_RK); const bf16_t* RV = WSP(bf16_t, WS_RV); const bf16_t* SG = WSP(bf16_t, WS_SG);
    const bf16_t* S = WSP(bf16_t, WS_S) + (size_t)unit * 32768; bf16_t* RY = WSP(bf16_t, WS_RYMY);
    const float lg = log2gamma(h);
    char* lds = (char*)F.lds; const int lbase = (int)(uintptr_t)F.lds;
    bf16x8 qr[8];
    { const bf16_t* qp = RQ + (size_t)(t0 + 32 * w + r32) * 1024 + h * 128 + hi * 8;
#pragma unroll
      for (int d0 = 0; d0 < 8; ++d0) qr[d0] = *(const bf16x8*)(qp + d0 * 16); }
    f32x16 o[8];
#pragma unroll
    for (int d = 0; d < 8; ++d) o[d] = f32x16{};
    if (sc > 0) {
#pragma unroll
        for (int i = 0; i < 8; ++i) *(u32x4*)(lds + (tid + 512 * i) * 16) = *(const u32x4*)((const char*)S + (tid + 512 * i) * 16);
        __syncthreads();
        const int svb = lbase + v_rd_base(lane);
#define QS_STEP(D0) do { s16x4 l0, h0, l1, h1, l2, h2, l3, h3; \
        tr_frag_issue<8, D0, 0>(svb, l0, h0); tr_frag_issue<8, D0, 1>(svb, l1, h1); tr_frag_issue<8, D0, 2>(svb, l2, h2); tr_frag_issue<8, D0, 3>(svb, l3, h3); \
        asm volatile("s_waitcnt lgkmcnt(0)" ::: "memory"); SBAR(); \
        o[D0] = __builtin_amdgcn_mfma_f32_32x32x16_bf16(qr[0], PKF(l0, h0), o[D0], 0, 0, 0); o[D0] = __builtin_amdgcn_mfma_f32_32x32x16_bf16(qr[1], PKF(l1, h1), o[D0], 0, 0, 0); \
        o[D0] = __builtin_amdgcn_mfma_f32_32x32x16_bf16(qr[2], PKF(l2, h2), o[D0], 0, 0, 0); o[D0] = __builtin_amdgcn_mfma_f32_32x32x16_bf16(qr[3], PKF(l3, h3), o[D0], 0, 0, 0); SBAR(); \
        tr_frag_issue<8, D0, 4>(svb, l0, h0); tr_frag_issue<8, D0, 5>(svb, l1, h1); tr_frag_issue<8, D0, 6>(svb, l2, h2); tr_frag_issue<8, D0, 7>(svb, l3, h3); \
        asm volatile("s_waitcnt lgkmcnt(0)" ::: "memory"); SBAR(); \
        o[D0] = __builtin_amdgcn_mfma_f32_32x32x16_bf16(qr[4], PKF(l0, h0), o[D0], 0, 0, 0); o[D0] = __builtin_amdgcn_mfma_f32_32x32x16_bf16(qr[5], PKF(l1, h1), o[D0], 0, 0, 0); \
        o[D0] = __builtin_amdgcn_mfma_f32_32x32x16_bf16(qr[6], PKF(l2, h2), o[D0], 0, 0, 0); o[D0] = __builtin_amdgcn_mfma_f32_32x32x16_bf16(qr[7], PKF(l3, h3), o[D0], 0, 0, 0); SBAR(); } while (0)
        QS_STEP(0); QS_STEP(1); QS_STEP(2); QS_STEP(3); QS_STEP(4); QS_STEP(5); QS_STEP(6); QS_STEP(7);
#undef QS_STEP
        float rbase = lg * (float)(32 * w + 4 * hi + 1); asm volatile("" : "+v"(rbase));
#pragma unroll
        for (int r = 0; r < 16; ++r) { const float g = fast_exp2(rbase + lg * (float)((r & 3) + 8 * (r >> 2)));
#pragma unroll
            for (int d = 0; d < 8; ++d) o[d][r] *= g; }
    }
    const int vvb = lbase + 81920 + v_rd_base(lane); const char* Kt = lds + 65536;
    const int nq = 32 * w + r32;
    for (int tt = 0; tt < 4; ++tt) {
#pragma unroll
        for (int i = 0; i < 2; ++i) { const int key = (tid >> 4) + 32 * i, c8 = (tid & 15) * 8;
            *(u32x4*)(lds + 65536 + KSWZ(key, c8 * 2)) = *(const u32x4*)(RK + (size_t)(t0 + tt * 64 + key) * 1024 + h * 128 + c8); }
#pragma unroll
        for (int i = 0; i < 4; ++i) { const int key = (tid >> 5) + 16 * i, c8 = (tid & 31) * 8;
            *(u32x4*)(lds + 81920 + v_st<8>(key, c8)) = *(const u32x4*)(RV + (size_t)(t0 + tt * 64 + key) * 2048 + h * 256 + c8); }
        __syncthreads();
        if (tt <= (w >> 1)) {
            f32x16 p0 = f32x16{}, p1 = f32x16{};
            { const bf16_t* qp2 = RQ + (size_t)(t0 + 32 * w + r32) * 1024 + h * 128 + hi * 8; asm volatile("" : "+v"(qp2));
#pragma unroll
              for (int d0 = 0; d0 < 8; ++d0) qr[d0] = *(const bf16x8*)(qp2 + d0 * 16); }
#pragma unroll
            for (int d0 = 0; d0 < 8; ++d0) { const int cb = (d0 * 16 + hi * 8) * 2;
                const bf16x8 k0 = *(const bf16x8*)(Kt + KSWZ(r32, cb)), k1 = *(const bf16x8*)(Kt + KSWZ(32 + r32, cb));
                p0 = __builtin_amdgcn_mfma_f32_32x32x16_bf16(k0, qr[d0], p0, 0, 0, 0); p1 = __builtin_amdgcn_mfma_f32_32x32x16_bf16(k1, qr[d0], p1, 0, 0, 0); }
            float dbase = (float)(nq - tt * 64 - 4 * hi); asm volatile("" : "+v"(dbase));
#pragma unroll
            for (int r = 0; r < 16; ++r) { const float dd = dbase - (float)((r & 3) + 8 * (r >> 2));
                p0[r] *= fast_exp2(lg * fabsf(dd)); p1[r] *= fast_exp2(lg * fabsf(dd - 32.f)); }
            bf16x8 pa0, pa1, pa2, pa3; p_to_frags(p0, p1, pa0, pa1, pa2, pa3);
            pv_one<8, 0>(o[0], vvb, pa0, pa1, pa2, pa3); pv_one<8, 1>(o[1], vvb, pa0, pa1, pa2, pa3); pv_one<8, 2>(o[2], vvb, pa0, pa1, pa2, pa3); pv_one<8, 3>(o[3], vvb, pa0, pa1, pa2, pa3);
            pv_one<8, 4>(o[4], vvb, pa0, pa1, pa2, pa3); pv_one<8, 5>(o[5], vvb, pa0, pa1, pa2, pa3); pv_one<8, 6>(o[6], vvb, pa0, pa1, pa2, pa3); pv_one<8, 7>(o[7], vvb, pa0, pa1, pa2, pa3);
        }
        __syncthreads();
    }
#pragma unroll
    for (int r = 0; r < 16; ++r) {
        float s = 0.f;
#pragma unroll
        for (int d = 0; d < 8; ++d) s += o[d][r];
        const float mu = half_sum32(s) * (1.0f / 256.0f);
        float q = 0.f;
#pragma unroll
        for (int d = 0; d < 8; ++d) { const float dd = o[d][r] - mu; q += dd * dd; }
        const float rstd = 1.0f / sqrtf(half_sum32(q) * (1.0f / 256.0f) + EPS);
        const size_t row = (size_t)(t0 + 32 * w + crow(r, hi));
#pragma unroll
        for (int d = 0; d < 8; ++d) { const int col = h * 256 + 32 * d + r32;
            const float z = (o[d][r] - mu) * rstd * F.g_ret[col] * bf2f(SG[row * 2048 + col]);
            RY[row * 4096 + col] = (bf16_t)(cvt_pk_bf16(z, 0.f) & 0xffffu); }
        asm volatile("" ::: "memory"); SBAR();
    }
}

constexpr int AT_BUF = 40960, AT_KP = 16384, AT_V = 24576, AT_WS = 81920;
__device__ __forceinline__ void mla_unit(Frame& F, int b, int h, int qb) {
    const int tid = F_TID, lane = F_LANE, w = F_WAVE, r32 = lane & 31, hi = lane >> 5;
    const bf16_t* QN = WSP(bf16_t, WS_QN); const bf16_t* QP = WSP(bf16_t, WS_QP); const bf16_t* KN = WSP(bf16_t, WS_KN); const bf16_t* KPE = WSP(bf16_t, WS_KPE); const bf16_t* V = WSP(bf16_t, WS_V);
    bf16_t* MY = WSP(bf16_t, WS_RYMY) + 2048;
    char* lds = (char*)F.lds; const int lbase = (int)(uintptr_t)F.lds;
    float* wsf = (float*)(lds + AT_WS) + w * 64; float* li_l = wsf; float* al_l = wsf + 32;
    const size_t rb = (size_t)b * SEQ; const int q0 = qb * 256;
    bf16x8 qn[8], qp[4];
    { const size_t row = rb + q0 + 32 * w + r32;
#pragma unroll
      for (int d0 = 0; d0 < 8; ++d0) qn[d0] = *(const bf16x8*)(QN + row * 2048 + h * 128 + d0 * 16 + hi * 8);
#pragma unroll
      for (int d0 = 0; d0 < 4; ++d0) qp[d0] = *(const bf16x8*)(QP + row * 1024 + h * 64 + d0 * 16 + hi * 8); }
    const int NT = 4 * qb + 4, NTW = 4 * qb + (w >> 1) + 1;
    const int skey = tid >> 4, sc8 = (tid & 15) * 8, pkey = tid >> 3, pc8 = (tid & 7) * 8;
    u32x4 sk0, sk1, sv0, sv1, sp;
#define AT_LOAD(t) do { const size_t kb = rb + (size_t)(t) * 64; \
        sk0 = *(const u32x4*)(KN + (kb + skey) * 2048 + h * 128 + sc8); sk1 = *(const u32x4*)(KN + (kb + 32 + skey) * 2048 + h * 128 + sc8); \
        sv0 = *(const u32x4*)(V + (kb + skey) * 2048 + h * 128 + sc8);  sv1 = *(const u32x4*)(V + (kb + 32 + skey) * 2048 + h * 128 + sc8); \
        sp = *(const u32x4*)(KPE + (kb + pkey) * 64 + pc8); } while (0)
#define AT_WRITE(bf) do { char* B_ = lds + (bf) * AT_BUF; \
        *(u32x4*)(B_ + KSWZ(skey, sc8 * 2)) = sk0; *(u32x4*)(B_ + KSWZ(32 + skey, sc8 * 2)) = sk1; \
        *(u32x4*)(B_ + AT_V + v_st<4>(skey, sc8)) = sv0; *(u32x4*)(B_ + AT_V + v_st<4>(32 + skey, sc8)) = sv1; \
        *(u32x4*)(B_ + AT_KP + PSWZ(pkey, pc8 * 2)) = sp; } while (0)
    float m_reg = -1e30f, l_reg = 0.f; f32x16 o[4];
#pragma unroll
    for (int d = 0; d < 4; ++d) o[d] = f32x16{};
    AT_LOAD(0); AT_WRITE(0); __syncthreads();
    for (int t = 0; t < NT; ++t) {
        const int bf = t & 1;
        if (t + 1 < NT) AT_LOAD(t + 1);
        if (t < NTW) {
            const char* Kt = lds + bf * AT_BUF; const char* Pt = Kt + AT_KP; const int vvb = lbase + bf * AT_BUF + AT_V + v_rd_base(lane);
            f32x16 p0 = f32x16{}, p1 = f32x16{};
#pragma unroll
            for (int d0 = 0; d0 < 8; ++d0) { const int cb = (d0 * 16 + hi * 8) * 2;
                const bf16x8 k0 = *(const bf16x8*)(Kt + KSWZ(r32, cb)), k1 = *(const bf16x8*)(Kt + KSWZ(32 + r32, cb));
                p0 = __builtin_amdgcn_mfma_f32_32x32x16_bf16(k0, qn[d0], p0, 0, 0, 0); p1 = __builtin_amdgcn_mfma_f32_32x32x16_bf16(k1, qn[d0], p1, 0, 0, 0); }
#pragma unroll
            for (int d0 = 0; d0 < 4; ++d0) { const int cb = (d0 * 16 + hi * 8) * 2;
                const bf16x8 k0 = *(const bf16x8*)(Pt + PSWZ(r32, cb)), k1 = *(const bf16x8*)(Pt + PSWZ(32 + r32, cb));
                p0 = __builtin_amdgcn_mfma_f32_32x32x16_bf16(k0, qp[d0], p0, 0, 0, 0); p1 = __builtin_amdgcn_mfma_f32_32x32x16_bf16(k1, qp[d0], p1, 0, 0, 0); }
            float pmax = p0[0];
#pragma unroll
            for (int r = 1; r < 16; ++r) pmax = fmaxf(pmax, p0[r]);
#pragma unroll
            for (int r = 0; r < 16; ++r) pmax = fmaxf(pmax, p1[r]);
            { auto rr = __builtin_amdgcn_permlane32_swap(__float_as_uint(pmax), __float_as_uint(pmax), false, false); pmax = fmaxf(__uint_as_float(rr[0]), __uint_as_float(rr[1])); }
            float alpha = 1.f;
            if (!__all(pmax <= m_reg)) { const float mn = fmaxf(m_reg, pmax); alpha = fast_exp2(m_reg - mn); m_reg = mn; }
#pragma unroll
            for (int r = 0; r < 16; ++r) { p0[r] = fast_exp2(p0[r] - m_reg); p1[r] = fast_exp2(p1[r] - m_reg); }
            float ps = 0.f;
#pragma unroll
            for (int r = 0; r < 16; ++r) ps += p0[r] + p1[r];
            { auto rr = __builtin_amdgcn_permlane32_swap(__float_as_uint(ps), __float_as_uint(ps), false, false); ps = __uint_as_float(rr[0]) + __uint_as_float(rr[1]); }
            l_reg = l_reg * alpha + ps;
            if (__any(alpha < 1.f)) { if (hi == 0) al_l[r32] = alpha; LDS_WAIT();
#pragma unroll
                for (int r = 0; r < 16; ++r) { const float a = al_l[crow(r, hi)];
#pragma unroll
                    for (int d = 0; d < 4; ++d) o[d][r] *= a; } }
            bf16x8 pa0, pa1, pa2, pa3; p_to_frags(p0, p1, pa0, pa1, pa2, pa3);
            pv_one<4, 0>(o[0], vvb, pa0, pa1, pa2, pa3); pv_one<4, 1>(o[1], vvb, pa0, pa1, pa2, pa3); pv_one<4, 2>(o[2], vvb, pa0, pa1, pa2, pa3); pv_one<4, 3>(o[3], vvb, pa0, pa1, pa2, pa3);
        }
        if (t + 1 < NT) AT_WRITE(bf ^ 1);
        __syncthreads();
    }
    if (hi == 0) li_l[r32] = l_reg; LDS_WAIT();
    const size_t orow0 = rb + q0 + 32 * w;
#pragma unroll
    for (int r = 0; r < 16; ++r) { const float rl = fast_rcp(li_l[crow(r, hi)]); bf16_t* op = MY + (orow0 + crow(r, hi)) * 4096 + h * 128 + r32;
#pragma unroll
        for (int d = 0; d < 4; ++d) op[32 * d] = (bf16_t)(cvt_pk_bf16(o[d][r] * rl, 0.f) & 0xffffu); }
    __syncthreads();
#undef AT_LOAD
#undef AT_WRITE
}

#if DBG
__device__ __forceinline__ unsigned hash_u32(unsigned x) { x ^= x >> 16; x *= 0x7feb352du; x ^= x >> 15; x *= 0x846ca68bu; x ^= x >> 16; return x; }
__device__ __forceinline__ void dbg_report(Frame& F, int stage, float err, float tol) {
    const float q = err / tol; if (!(q < 1.0f)) { const int bucket = !(q < 100.f) ? 0 : q >= 30.f ? 1 : q >= 10.f ? 2 : q >= 3.f ? 3 : 4; atomicMax(WSP(unsigned, WS_CTL) + CW_ERR, (unsigned)(1000 - (stage * 10 + bucket))); }
}
__device__ __forceinline__ void dbg_code(Frame& F, int code, float err, float tol) { if (!(err / tol < 1.0f)) atomicMax(WSP(unsigned, WS_CTL) + CW_ERR, (unsigned)(1000 - code)); }
__device__ __forceinline__ float wdot(const bf16_t* a, int K, const float* W, int ldw, int col, const float* gain, int lane) {
    float s = 0.f; for (int k = lane; k < K; k += 64) { float av = bf2f(a[k]); if (gain) av *= gain[k]; s += av * W[(size_t)k * ldw + col]; } return wave_sum(s);
}
__device__ __forceinline__ void rope_cs(Frame& F, int row, int i, int half, float& c, float& s) { const float inv = powf(10000.0f, -(float)i / (float)half); sincos_acc((float)F.pos[row] * inv, s, c); }
__device__ __forceinline__ int pos128(int j) { const int n = j >> 6, i = j & 63; return 32 * (i >> 4) + 8 * ((i >> 2) & 3) + 4 * n + (i & 3); }
__device__ __forceinline__ int pos64(int j) { const int n = j >> 5, i = j & 31; return 32 * (i >> 4) + 8 * ((i >> 2) & 3) + 4 * n + (i & 3); }
__device__ __forceinline__ void chk_p0(Frame& F) {
    const size_t gt = (size_t)blockIdx.x * 512 + F_TID, NT_ = (size_t)gridDim.x * 512;
    for (size_t i = gt; i < (size_t)N1P * 2048; i += NT_) { const int c = (int)(i >> 11), k = (int)(i & 2047); const int lc = lcmap<MAP_G1>(c); const float e = lc >= 0 ? F.w_in[(size_t)k * N_IN + lc] : 0.f; dbg_code(F, 10, fabsf(bf2f(WSP(bf16_t, WS_WI)[i]) - e), 0.001f + 0.01f * fabsf(e)); }
    for (size_t i = gt; i < (size_t)3072 * 512; i += NT_) { const int c = (int)(i >> 9), k = (int)(i & 511); const float e = F.w_q_b[(size_t)k * 3072 + lcmap<MAP_Q>(c)] * F.g_qa[k]; dbg_code(F, 11, fabsf(bf2f(WSP(bf16_t, WS_WQ)[i]) - e), 0.001f + 0.01f * fabsf(e)); }
    for (size_t i = gt; i < (size_t)4096 * 512; i += NT_) { const int c = (int)(i >> 9), k = (int)(i & 511); const float e = F.w_kv_b[(size_t)k * 4096 + lcmap<MAP_KV>(c)] * F.g_kva[k]; dbg_code(F, 12, fabsf(bf2f(WSP(bf16_t, WS_WKV)[i]) - e), 0.001f + 0.01f * fabsf(e)); }
    for (size_t i = gt; i < (size_t)2048 * 4096; i += NT_) { const int c = (int)(i >> 12), k = (int)(i & 4095); const float e = k < 2048 ? F.w_ret_o[(size_t)k * 2048 + nat32(c)] : F.w_mla_o[(size_t)(k - 2048) * 2048 + nat32(c)]; dbg_code(F, 13, fabsf(bf2f(WSP(bf16_t, WS_WRM)[i]) - e), 0.001f + 0.01f * fabsf(e)); }
    for (size_t i = gt; i < (size_t)2048 * 2048; i += NT_) { const int c = (int)(i >> 11), k = (int)(i & 2047); const float e = F.w_out[(size_t)k * 2048 + nat32(c)]; dbg_code(F, 14, fabsf(bf2f(WSP(bf16_t, WS_WO)[i]) - e), 0.001f + 0.01f * fabsf(e)); }
    for (int row = blockIdx.x * 8 + F_WAVE; row < T; row += gridDim.x * 8) { float s = 0.f; for (int k = F_LANE; k < DM; k += 64) { const float v = F.x[(size_t)row * DM + k]; s += v * v; } const float rinv = 1.0f / sqrtf(wave_sum(s) / DM + EPS);
        for (int k = F_LANE; k < DM; k += 64) { const float e = F.x[(size_t)row * DM + k] * rinv * F.g_mix[k]; dbg_code(F, 15, fabsf(bf2f(WSP(bf16_t, WS_U)[(size_t)row * DM + k]) - e), 0.001f + 0.01f * fabsf(e)); } }
}
__device__ __forceinline__ void chk_p1(Frame& F) {
#ifdef SWAP_EXP
    const bf16_t* CK_SGR = WSP(bf16_t, WS_RV); const bf16_t* CK_SGM = WSP(bf16_t, WS_SG); const bf16_t* CK_RV = (const bf16_t*)F.out; const bf16_t* CK_SG = (const bf16_t*)F.out + (size_t)T * 2048;
#else
    const bf16_t* CK_SGR = (const bf16_t*)F.out; const bf16_t* CK_SGM = (const bf16_t*)F.out + (size_t)T * 2048; const bf16_t* CK_RV = WSP(bf16_t, WS_RV); const bf16_t* CK_SG = WSP(bf16_t, WS_SG);
#endif
    const int lane = F_LANE;
  for (int smp = 0; smp < 4; ++smp) {
    const int sid = (blockIdx.x * 8 + F_WAVE) * 4 + smp; const unsigned hs = hash_u32(sid * 7 + 3);
    const int row = sid; int lc = (hs >> 13) % N_IN; if (sid & 1) lc = LO_KPE + (lc & 63) ; if ((sid & 7) == 2) lc = lc % 2048;
    const bf16_t* U = WSP(bf16_t, WS_U) + (size_t)row * DM;
    float expect, got;
    if (lc < LO_RV) {
        const bool isk = lc >= LO_RK; const int l = lc - (isk ? LO_RK : 0), head = l >> 7, j = l & 127, i = j & 63; const int base = (isk ? LO_RK : 0) + head * 128;
        const float x1 = wdot(U, DM, F.w_in, N_IN, base + i, nullptr, lane), x2 = wdot(U, DM, F.w_in, N_IN, base + 64 + i, nullptr, lane); float c, s; rope_cs(F, row, i, 64, c, s);
        expect = (j < 64 ? x1 * c - x2 * s : x2 * c + x1 * s) * (isk ? RK_SCALE : 1.0f);
        got = bf2f((isk ? WSP(bf16_t, WS_RK) : WSP(bf16_t, WS_RQ))[(size_t)row * 1024 + head * 128 + pos128(j)]);
    } else if (lc >= LO_KPE && lc < LO_GRET) {
        const int j = lc - LO_KPE, i = j & 31; const float x1 = wdot(U, DM, F.w_in, N_IN, LO_KPE + i, nullptr, lane), x2 = wdot(U, DM, F.w_in, N_IN, LO_KPE + 32 + i, nullptr, lane); float c, s; rope_cs(F, row, i, 32, c, s);
        expect = j < 32 ? x1 * c - x2 * s : x2 * c + x1 * s; got = bf2f(WSP(bf16_t, WS_KPE)[(size_t)row * 64 + pos64(j)]);
    } else {
        const float v = wdot(U, DM, F.w_in, N_IN, lc, nullptr, lane);
        if (lc < LO_RG) { expect = v; got = bf2f(CK_RV[(size_t)row * 2048 + lc - LO_RV]); }
        else if (lc < LO_CQ) { expect = v / (1.0f + expf(-v)); got = bf2f(CK_SG[(size_t)row * 2048 + lc - LO_RG]); }
        else if (lc < LO_CKV) { expect = v; got = bf2f(WSP(bf16_t, WS_CQ)[(size_t)row * 512 + lc - LO_CQ]); }
        else if (lc < LO_KPE) { expect = v; got = bf2f(WSP(bf16_t, WS_CKV)[(size_t)row * 512 + lc - LO_CKV]); }
        else if (lc < LO_GMLA) { expect = 1.0f / (1.0f + expf(-v)); got = bf2f(CK_SGR[(size_t)row * 2048 + lc - LO_GRET]); }
        else { expect = 1.0f / (1.0f + expf(-v)); got = bf2f(CK_SGM[(size_t)row * 2048 + lc - LO_GMLA]); }
    }
    if (row == 6064 && lane == 0) { WSP(float, WS_CTL)[8] = got; WSP(float, WS_CTL)[9] = expect; }
    if (lc >= LO_GRET && lc < LO_GMLA && !(fabsf(got - expect) / (0.03f + 0.02f * fabsf(expect)) < 1.0f)) atomicMax(WSP(unsigned, WS_CTL) + CW_ERR + 1, 0x7fffffffu - (unsigned)(row * 2048 + (lc - LO_GRET)));
    { const int sec = lc < LO_RK ? 0 : lc < LO_RV ? 1 : lc < LO_RG ? 2 : lc < LO_CQ ? 3 : lc < LO_CKV ? 4 : lc < LO_KPE ? 5 : lc < LO_GRET ? 6 : lc < LO_GMLA ? 7 : 8; dbg_code(F, 20 + sec, fabsf(got - expect), 0.03f + 0.02f * fabsf(expect)); }
    {
        float sq = 0.f, sk = 0.f; for (int k = lane; k < 512; k += 64) { const float a = bf2f(WSP(bf16_t, WS_CQ)[(size_t)row * 512 + k]), b2 = bf2f(WSP(bf16_t, WS_CKV)[(size_t)row * 512 + k]); sq += a * a; sk += b2 * b2; }
        sq = wave_sum(sq); sk = wave_sum(sk);
        dbg_code(F, 29, fabsf(WSP(float, WS_CTL + CTL_SSQ_Q)[row] - sq), 0.02f * sq + 1e-3f); dbg_code(F, 29, fabsf(WSP(float, WS_CTL + CTL_SSQ_KV)[row] - sk), 0.02f * sk + 1e-3f);
    }
  }
}
__device__ __forceinline__ void chk_p2(Frame& F) {
    const int lane = F_LANE;
  for (int smp = 0; smp < 4; ++smp) {
    const int sid = (blockIdx.x * 8 + F_WAVE) * 4 + smp; const unsigned hs = hash_u32(sid * 11 + 5);
    const int row = sid, h = (hs >> 13) & 15, d = (hs >> 17) % 192, which = (hs >> 25) % 3;
    const bf16_t* cq = WSP(bf16_t, WS_CQ) + (size_t)row * 512; const bf16_t* ckv = WSP(bf16_t, WS_CKV) + (size_t)row * 512;
    float expect, got;
    if (which == 0) {
        float s = 0.f; for (int k = lane; k < 512; k += 64) { const float a = bf2f(cq[k]); s += a * a; } const float rinv = 1.0f / sqrtf(wave_sum(s) / 512.f + EPS);
        if (d < 128) { expect = wdot(cq, 512, F.w_q_b, 3072, h * 192 + d, F.g_qa, lane) * rinv * C2Q; got = bf2f(WSP(bf16_t, WS_QN)[(size_t)row * 2048 + h * 128 + d]); }
        else { const int j = d - 128, i = j & 31; const float x1 = wdot(cq, 512, F.w_q_b, 3072, h * 192 + 128 + i, F.g_qa, lane), x2 = wdot(cq, 512, F.w_q_b, 3072, h * 192 + 160 + i, F.g_qa, lane); float c, sn; rope_cs(F, row, i, 32, c, sn);
            expect = (j < 32 ? x1 * c - x2 * sn : x2 * c + x1 * sn) * rinv * C2Q; got = bf2f(WSP(bf16_t, WS_QP)[(size_t)row * 1024 + h * 64 + pos64(j)]); }
        dbg_report(F, 3, fabsf(got - expect), 0.03f * C2Q * 4.f + 0.02f * fabsf(expect));
    } else {
        float s = 0.f; for (int k = lane; k < 512; k += 64) { const float a = bf2f(ckv[k]); s += a * a; } const float rinv = 1.0f / sqrtf(wave_sum(s) / 512.f + EPS);
        const int dd = d & 127;
        expect = wdot(ckv, 512, F.w_kv_b, 4096, h * 256 + (which == 2 ? 128 : 0) + dd, F.g_kva, lane) * rinv; got = bf2f((which == 2 ? WSP(bf16_t, WS_V) : WSP(bf16_t, WS_KN))[(size_t)row * 2048 + h * 128 + dd]);
        dbg_report(F, 3, fabsf(got - expect), 0.03f + 0.02f * fabsf(expect));
    }
  }
}
__device__ __forceinline__ void chk_ret(Frame& F) {
    const int tid = F_TID; float* sc = (float*)(char*)F.lds; float* red = sc + 4096;
    const bf16_t* RQ = WSP(bf16_t, WS_RQ); const bf16_t* RK = WSP(bf16_t, WS_RK); const bf16_t* RV = WSP(bf16_t, WS_RV);
    for (int smp = 0; smp < 32; ++smp) {
        const int grow = blockIdx.x * 32 + smp; const unsigned hs = hash_u32(grow * 13 + 7); const int b = grow >> 12, n = grow & 4095, h = hs & 7;
        const size_t rb = (size_t)b * SEQ; const int pend = (n / 64 + 1) * 64; const float lg = log2gamma(h);
        const bf16_t* q = RQ + (rb + n) * 1024 + h * 128;
        for (int p = tid; p < pend; p += 512) { const bf16_t* k = RK + (rb + p) * 1024 + h * 128; float s = 0.f; for (int d = 0; d < 128; ++d) s += bf2f(q[d]) * bf2f(k[d]); sc[p] = s * exp2f(lg * fabsf((float)(n - p))); }
        __syncthreads();
        float o = 0.f;
        if (tid < 256) { for (int p = 0; p < pend; ++p) o += sc[p] * bf2f(RV[(rb + p) * 2048 + h * 256 + tid]); red[tid] = o; }
        __syncthreads();
        if (tid < 256) { float mu = 0.f; for (int i = 0; i < 256; ++i) mu += red[i]; mu /= 256.f; float var = 0.f; for (int i = 0; i < 256; ++i) { const float dd = red[i] - mu; var += dd * dd; } var /= 256.f;
            const float expect = (o - mu) / sqrtf(var + EPS) * F.g_ret[h * 256 + tid] * bf2f(WSP(bf16_t, WS_SG)[(rb + n) * 2048 + h * 256 + tid]);
            const float got = bf2f(WSP(bf16_t, WS_RYMY)[(rb + n) * 4096 + h * 256 + tid]);
            dbg_report(F, 4, fabsf(got - expect), 0.04f + 0.03f * fabsf(expect)); }
        __syncthreads();
    }
}
__device__ __forceinline__ void chk_mla(Frame& F) {
    const int tid = F_TID; float* sc = (float*)(char*)F.lds; float* red = sc + 4096;
    for (int smp = 0; smp < 32; ++smp) {
        const int grow = blockIdx.x * 32 + smp; const unsigned hs = hash_u32(grow * 17 + 9); const int b = grow >> 12, n = grow & 4095, h = hs & 15;
        const size_t rb = (size_t)b * SEQ; const int pend = (n / 64 + 1) * 64;
        const bf16_t* qn = WSP(bf16_t, WS_QN) + (rb + n) * 2048 + h * 128; const bf16_t* qp = WSP(bf16_t, WS_QP) + (rb + n) * 1024 + h * 64;
        for (int p = tid; p < pend; p += 512) { const bf16_t* kn = WSP(bf16_t, WS_KN) + (rb + p) * 2048 + h * 128; const bf16_t* kp = WSP(bf16_t, WS_KPE) + (rb + p) * 64; float s = 0.f;
            for (int d = 0; d < 128; ++d) s += bf2f(qn[d]) * bf2f(kn[d]); for (int d = 0; d < 64; ++d) s += bf2f(qp[d]) * bf2f(kp[d]); sc[p] = s; }
        __syncthreads();
        float o = 0.f, l = 0.f;
        if (tid < 128) { float mx = -1e30f; for (int p = 0; p < pend; ++p) mx = fmaxf(mx, sc[p]);
            for (int p = 0; p < pend; ++p) { const float e = exp2f(sc[p] - mx); l += e; o += e * bf2f(WSP(bf16_t, WS_V)[(rb + p) * 2048 + h * 128 + tid]); }
            o /= l; red[tid] = fabsf(o); }
        __syncthreads();
        if (tid < 128) { float mxa = 0.f; for (int i = 0; i < 128; ++i) mxa = fmaxf(mxa, red[i]);
            const float got = bf2f(WSP(bf16_t, WS_RYMY)[(rb + n) * 4096 + 2048 + h * 128 + tid]);
            dbg_report(F, 5, fabsf(got - o), 0.03f * mxa + 0.02f * fabsf(o)); }
        __syncthreads();
    }
}
__device__ __forceinline__ void chk_sgr_full(Frame& F) {
    unsigned* ctl = WSP(unsigned, WS_CTL); const bf16_t* SGRp = (const bf16_t*)F.out;
    const int colb = (blockIdx.x & 7) * 256 + (F_TID & 255), rhalf = F_TID >> 8;
    const int rowb = (blockIdx.x >> 3) * 256;
    for (int rr = 0; rr < 128; rr += 8) {
        float acc[8]; for (int j = 0; j < 8; ++j) acc[j] = 0.f;
        const int r0 = rowb + rhalf * 128 + rr;
        for (int k = 0; k < DM; ++k) { const float w = F.w_in[(size_t)k * N_IN + LO_GRET + colb];
#pragma unroll
            for (int j = 0; j < 8; ++j) acc[j] += bf2f(WSP(bf16_t, WS_U)[(size_t)(r0 + j) * DM + k]) * w; }
#pragma unroll
        for (int j = 0; j < 8; ++j) { const float e = 1.0f / (1.0f + expf(-acc[j])), g = bf2f(SGRp[(size_t)(r0 + j) * 2048 + colb]);
            if (!(fabsf(g - e) < 0.03f)) { atomicAdd(ctl + 16, 1u); atomicAdd(ctl + 32 + (((r0 + j) >> 8) * 8 + (colb >> 8)), 1u); atomicAdd(ctl + 288 + ((r0 + j) & 255), 1u); } }
    }
}
__device__ __forceinline__ void chk_p5(Frame& F) {
    const int lane = F_LANE;
    for (int smp = 0; smp < 4; ++smp) { const int row = (blockIdx.x * 8 + F_WAVE) * 4 + smp; const unsigned hs = hash_u32(row * 19 + 11); const int col = hs % 2048;
        const bf16_t* ry = WSP(bf16_t, WS_RYMY) + (size_t)row * 4096;
        const float y1 = wdot(ry, 2048, F.w_ret_o, 2048, col, nullptr, lane), y2 = wdot(ry + 2048, 2048, F.w_mla_o, 2048, col, nullptr, lane);
        const float g1 = bf2f(((const bf16_t*)F.out)[(size_t)row * 2048 + col]), g2 = bf2f(((const bf16_t*)F.out + (size_t)T * 2048)[(size_t)row * 2048 + col]);
        const float expect = g1 * y1 + g2 * y2, got = bf2f(WSP(bf16_t, WS_MERGED)[(size_t)row * 2048 + col]);
        dbg_report(F, 6, fabsf(got - expect), 0.02f + 0.02f * fabsf(expect)); }
    const unsigned hs = hash_u32((blockIdx.x * 8 + F_WAVE) * 64 + lane + 77);
    { const int c = hs % 8192, k = (hs >> 16) % 2048; const float e = F.w_up[(size_t)k * 8192 + nat32(c)] * F.g_mlp[k]; dbg_report(F, 6, fabsf(bf2f(WSP(bf16_t, WS_WU)[(size_t)c * 2048 + k]) - e), 0.001f + 0.01f * fabsf(e)); }
    { const int c = hs % 2048, k = (hs >> 16) % 8192; const float e = F.w_down[(size_t)k * 2048 + nat32(c)]; dbg_report(F, 6, fabsf(bf2f(WSP(bf16_t, WS_WD)[(size_t)c * 8192 + k]) - e), 0.001f + 0.01f * fabsf(e)); }
}
__device__ __forceinline__ void chk_p6(Frame& F) {
    const int lane = F_LANE;
    for (int smp = 0; smp < 4; ++smp) { const int row = (blockIdx.x * 8 + F_WAVE) * 4 + smp; const unsigned hs = hash_u32(row * 23 + 13); const int col = hs % 2048;
        const float expect = F.x[(size_t)row * 2048 + col] + wdot(WSP(bf16_t, WS_MERGED) + (size_t)row * 2048, 2048, F.w_out, 2048, col, nullptr, lane);
        dbg_report(F, 7, fabsf(F.out[(size_t)row * 2048 + col] - expect), 0.02f + 0.02f * fabsf(expect));
        dbg_report(F, 7, fabsf(bf2f(WSP(bf16_t, WS_H1B)[(size_t)row * 2048 + col]) - expect), 0.03f + 0.02f * fabsf(expect));
        float s = 0.f; for (int k = lane; k < 2048; k += 64) { const float v = F.out[(size_t)row * 2048 + k]; s += v * v; } s = wave_sum(s);
        dbg_report(F, 7, fabsf(WSP(float, WS_CTL + CTL_SSQ_H1)[row] - s), 0.01f * s + 1e-3f); }
}
__device__ __forceinline__ void chk_p7(Frame& F) {
    const int lane = F_LANE;
    for (int smp = 0; smp < 4; ++smp) { const int row = (blockIdx.x * 8 + F_WAVE) * 4 + smp; const unsigned hs = hash_u32(row * 29 + 15); const int col = hs % 8192;
        const float rinv = 1.0f / sqrtf(WSP(float, WS_CTL + CTL_SSQ_H1)[row] / 2048.f + EPS);
        const float z = wdot(WSP(bf16_t, WS_H1B) + (size_t)row * 2048, 2048, F.w_up, 8192, col, F.g_mlp, lane) * rinv; const float r = fmaxf(z, 0.f), expect = r * r;
        dbg_report(F, 8, fabsf(bf2f(WSP(bf16_t, WS_HMID)[(size_t)row * 8192 + col]) - expect), 0.04f + 0.03f * fabsf(expect)); }
}
__device__ __forceinline__ void chk_p8(Frame& F) {
    const int lane = F_LANE;
    for (int smp = 0; smp < 4; ++smp) { const int row = (blockIdx.x * 8 + F_WAVE) * 4 + smp; const unsigned hs = hash_u32(row * 31 + 17); const int col = hs % 2048;
        const float expect = bf2f(WSP(bf16_t, WS_H1B)[(size_t)row * 2048 + col]) + wdot(WSP(bf16_t, WS_HMID) + (size_t)row * 8192, 8192, F.w_down, 2048, col, nullptr, lane);
        dbg_report(F, 9, fabsf(F.out[(size_t)row * 2048 + col] - expect), 0.05f + 0.03f * fabsf(expect));
        float s = 0.f; for (int k = lane; k < 2048; k += 64) { const float v = F.out[(size_t)row * 2048 + k]; s += v * v; } s = wave_sum(s);
        dbg_report(F, 9, fabsf(WSP(float, WS_CTL + CTL_SSQ_H2)[row] - s), 0.01f * s + 1e-3f); }
}
#endif

constexpr int N_PHASES = 10;
struct Args { const void* in[16]; float* out; unsigned char* ws; int ph_lo, ph_hi; };
__global__ void __launch_bounds__(512, 2) fwd_megakernel(Args args) {
    extern __shared__ __attribute__((aligned(16))) unsigned char lds_raw[];
    Frame F;
    F.lds = (LAS unsigned char*)lds_raw;

    F.G = gridDim.x; { const int bx = blockIdx.x; F.vcu = (F.G % 8 == 0) ? (bx % 8) * (F.G / 8) + bx / 8 : bx; }
    F.ws = args.ws; F.out = args.out;
    F.x = (const float*)args.in[0]; F.pos = (const int*)args.in[1]; F.g_mix = (const float*)args.in[2]; F.w_in = (const float*)args.in[3]; F.g_ret = (const float*)args.in[4];
    F.w_ret_o = (const float*)args.in[5]; F.g_qa = (const float*)args.in[6]; F.w_q_b = (const float*)args.in[7]; F.g_kva = (const float*)args.in[8]; F.w_kv_b = (const float*)args.in[9];
    F.w_mla_o = (const float*)args.in[10]; F.w_out = (const float*)args.in[11]; F.g_mlp = (const float*)args.in[12]; F.w_up = (const float*)args.in[13]; F.w_down = (const float*)args.in[14]; F.g_f = (const float*)args.in[15];
    volatile LAS unsigned* MISC = (volatile LAS unsigned*)(F.lds + MISC_OFF);
    for (int u = F_TID; u < (LDS_BYTES - RING_BYTES) / 4; u += 512) ((LAS unsigned*)(F.lds + RING_BYTES))[u] = 0u;
    __syncthreads();
    unsigned* ctl = WSP(unsigned, WS_CTL);
    const int lo = args.ph_lo, hi = args.ph_hi;
    XcdBarrier bar; bar.bar = ctl + CW_BAR; bar.x = 0; bar.st = nullptr;
    if (hi - lo > 1) bar = xcd_barrier_post(ctl + CW_BAR, MISC + 8);
#ifndef PH_MASK
#define PH_MASK 0x3ff
#endif
#define IN(k) ((((PH_MASK) >> (k)) & 1) && lo <= (k) && (k) < hi)
#define SEAM(k) do { if (lo <= (k) && (k) + 1 < hi) xcd_barrier(bar); } while (0)
    float* ssq_q = WSP(float, WS_CTL + CTL_SSQ_Q); float* ssq_kv = WSP(float, WS_CTL + CTL_SSQ_KV); float* ssq_h1 = WSP(float, WS_CTL + CTL_SSQ_H1); float* ssq_h2 = WSP(float, WS_CTL + CTL_SSQ_H2);
#ifdef SWAP_EXP
    bf16_t* SGR = WSP(bf16_t, WS_RV); bf16_t* SGM = WSP(bf16_t, WS_SG); bf16_t* P_RV = (bf16_t*)F.out; bf16_t* P_SG = (bf16_t*)F.out + (size_t)T * 2048;
#else
    bf16_t* SGR = (bf16_t*)F.out; bf16_t* SGM = (bf16_t*)F.out + (size_t)T * 2048; bf16_t* P_RV = WSP(bf16_t, WS_RV); bf16_t* P_SG = WSP(bf16_t, WS_SG);
#endif
    const int c = (int)blockIdx.x;

#ifdef START_DELAY_US
    if (lo == 0) { const unsigned long long t0 = __builtin_amdgcn_s_memrealtime(); while (__builtin_amdgcn_s_memrealtime() - t0 < (unsigned long long)(START_DELAY_US) * 100ull) __builtin_amdgcn_s_sleep(32); }
#endif
    if (IN(0)) { p0_prologue(F); }
    SEAM(0);
#if DBG
    if (IN(1)) { chk_p0(F); if (hi - lo > 1) xcd_barrier(bar); }
#endif
    if (IN(1)) {
        SchedG1 S{F.G, c, (const char*)WSP(bf16_t, WS_U), (const char*)WSP(bf16_t, WS_WI)};
        EpiG1 E{WSP(bf16_t, WS_RQ), WSP(bf16_t, WS_RK), P_RV, P_SG, WSP(bf16_t, WS_CQ), WSP(bf16_t, WS_CKV), WSP(bf16_t, WS_KPE), SGR, SGM,
                WSP(float, WS_RC64), WSP(float, WS_RS64), WSP(float, WS_RC32), WSP(float, WS_RS32), ssq_q, ssq_kv};
        pg8::gemm_phase<EpiG1, SchedG1, true>(F.lds, 2048, 2048, 32, S, E);
    }
    SEAM(1);
#if DBG
    if (IN(2)) { chk_p1(F); if (hi - lo > 1) xcd_barrier(bar); }
#endif
    if (IN(2)) {
        SchedG2 S{F.G, c, (const char*)WSP(bf16_t, WS_CQ), (const char*)WSP(bf16_t, WS_CKV), (const char*)WSP(bf16_t, WS_WQ), (const char*)WSP(bf16_t, WS_WKV)};
        EpiG2 E{WSP(bf16_t, WS_QN), WSP(bf16_t, WS_QP), WSP(bf16_t, WS_KN), WSP(bf16_t, WS_V), WSP(float, WS_RC32), WSP(float, WS_RS32), ssq_q, ssq_kv};
        pg8::gemm_phase<EpiG2, SchedG2, true>(F.lds, 512, 512, 8, S, E);
        __syncthreads();
        if (c >= F.G / 2) for (int u = c - F.G / 2; u < 256; u += F.G / 2) ret_local_unit(F, u);
    }
    SEAM(2);
#if DBG
    if (IN(3)) { chk_p2(F); if (hi - lo > 1) xcd_barrier(bar); }
#endif
    if (IN(3)) ret_scan(F);
    SEAM(3);
    if (IN(4)) {
        const int hb = F.vcu >> 3, pr = F.vcu & 7;
#ifndef NO_RETOUT
        for (int u = F.vcu; u < 256; u += F.G) ret_out_unit(F, u);
#endif
        __syncthreads();
#ifndef NO_MLA
        if (F.vcu < 256) { mla_unit(F, hb >> 4, hb & 15, 15 - pr); mla_unit(F, hb >> 4, hb & 15, pr); }
#endif
    }
    SEAM(4);
#if DBG
    if (IN(5)) { chk_ret(F); chk_mla(F); if (hi - lo > 1) xcd_barrier(bar); }
#endif
    if (IN(5)) {
        p5_convert(F);
        __syncthreads();
        SchedG5 S{F.G, c, (const char*)WSP(bf16_t, WS_RYMY), (const char*)WSP(bf16_t, WS_WRM)};
        EpiG5 E{SGR, SGM, WSP(bf16_t, WS_MERGED)};
        pg8::gemm_phase<EpiG5, SchedG5, false>(F.lds, 4096, 4096, 32, S, E);
    }
    SEAM(5);
#if DBG
    if (IN(6)) { chk_p5(F); if (hi - lo > 1) xcd_barrier(bar); }
#endif
    if (IN(6)) {
        SchedN S{F.G, c, 8, (const char*)WSP(bf16_t, WS_MERGED), (const char*)WSP(bf16_t, WS_WO), (size_t)256 * 2048 * 2, (size_t)256 * 2048 * 2};
        EpiG6 E{F.x, F.out, WSP(bf16_t, WS_H1B), ssq_h1};
        pg8::gemm_phase<EpiG6, SchedN, false>(F.lds, 2048, 2048, 32, S, E);
    }
    SEAM(6);
#if DBG
    if (IN(7)) { chk_p6(F); if (hi - lo > 1) xcd_barrier(bar); }
#endif
    if (IN(7)) {
        SchedN S{F.G, c, 32, (const char*)WSP(bf16_t, WS_H1B), (const char*)WSP(bf16_t, WS_WU), (size_t)256 * 2048 * 2, (size_t)256 * 2048 * 2};
        EpiG7 E{WSP(bf16_t, WS_HMID), ssq_h1};
        pg8::gemm_phase<EpiG7, SchedN, true>(F.lds, 2048, 2048, 32, S, E);
    }
    SEAM(7);
#if DBG
    if (IN(8)) { chk_p7(F); if (hi - lo > 1) xcd_barrier(bar); }
#endif
    if (IN(8)) {
        SchedN S{F.G, c, 8, (const char*)WSP(bf16_t, WS_HMID), (const char*)WSP(bf16_t, WS_WD), (size_t)256 * 8192 * 2, (size_t)256 * 8192 * 2};
        EpiG8 E{F.out, ssq_h2};
        pg8::gemm_phase<EpiG8, SchedN, false>(F.lds, 8192, 8192, 128, S, E);
    }
    SEAM(8);
#if DBG
    if (IN(9)) { chk_p8(F); if (hi - lo > 1) xcd_barrier(bar); }
#endif
    if (IN(9)) {
        const int gw = F.vcu * 8 + F_WAVE, NGW = F.G * 8;
#if DBG
        const unsigned ev = __hip_atomic_load(ctl + CW_ERR, __ATOMIC_RELAXED, __HIP_MEMORY_SCOPE_AGENT);
        const unsigned bt = __hip_atomic_load(ctl + CW_BAR + XB_TMO, __ATOMIC_RELAXED, __HIP_MEMORY_SCOPE_AGENT);
        float xfill0 = 0.f; float fill = bt ? sqrtf(98.f) : (ev ? sqrtf((float)(1000 - (int)ev)) : 0.f);
        { const unsigned iw = __hip_atomic_load(ctl + CW_ERR + 1, __ATOMIC_RELAXED, __HIP_MEMORY_SCOPE_AGENT);
          const float xg = __hip_atomic_load(WSP(float, WS_CTL) + 8, __ATOMIC_RELAXED, __HIP_MEMORY_SCOPE_AGENT), xe = __hip_atomic_load(WSP(float, WS_CTL) + 9, __ATOMIC_RELAXED, __HIP_MEMORY_SCOPE_AGENT);
          (void)xg; (void)xe;
#ifdef ONLY_STAGE1
          { const unsigned cnt = __hip_atomic_load(ctl + 16, __ATOMIC_RELAXED, __HIP_MEMORY_SCOPE_AGENT); unsigned nbt = 0, mx = 0; for (int i = 0; i < 256; ++i) { const unsigned v = __hip_atomic_load(ctl + 32 + i, __ATOMIC_RELAXED, __HIP_MEMORY_SCOPE_AGENT); nbt += v ? 1u : 0u; mx = v > mx ? v : mx; }
            (void)cnt; fill = sqrtf((10.f + floorf((float)nbt * 0.25f)) * 1e6f); xfill0 = (10.f + 2.f * floorf(log2f((float)mx + 1.f))) * 1e4f; }
#endif
          if (iw && false) { const unsigned rc = 0x7fffffffu - iw; const int row = rc >> 11, col = rc & 2047; const int mval = 10 + (row >> 8), ex = 1 + ((row >> 5) & 7); (void)col; fill = sqrtf((float)mval * __powf(10.f, (float)ex)); } }
#endif
        for (int m = gw; m < T; m += NGW) {
            f32x4* xr = (f32x4*)(F.out + (size_t)m * DM) + F_LANE; const f32x4* gr = (const f32x4*)F.g_f + F_LANE;
            const float rinv = 1.0f / sqrtf(ssq_h2[m] * (1.f / DM) + EPS);
#pragma unroll
            for (int j = 0; j < 8; ++j) { f32x4 v = xr[64 * j] * rinv * gr[64 * j];
#if DBG
                if (fill != 0.f) v = (f32x4){fill, fill, fill, fill};
                if (xfill0 != 0.f && m == 0 && j == 0 && F_LANE == 0) v[0] = xfill0;
#endif
                xr[64 * j] = v; }
        }
    }
#undef IN
#undef SEAM
}

extern "C" void kernel_launch(void* const* d_in, const int* in_sizes, int n_in, void* d_out, int out_size, void* d_ws, size_t ws_size, hipStream_t stream) {
    static int grid = 0;
    if (grid == 0) {
        if (n_in != 16 || out_size != T * DM || ws_size < WS_END) { fprintf(stderr, "kernel_launch: unexpected shapes (n_in %d, out %d, ws %zu < %zu)\n", n_in, out_size, ws_size, (size_t)WS_END); grid = -1; return; }
        int dev = 0, cus = 0, per_cu = 0;
        hipGetDevice(&dev); hipDeviceGetAttribute(&cus, hipDeviceAttributeMultiprocessorCount, dev);
        if (hipFuncSetAttribute((const void*)fwd_megakernel, hipFuncAttributeMaxDynamicSharedMemorySize, LDS_BYTES) != hipSuccess) { fprintf(stderr, "kernel_launch: hipFuncSetAttribute failed\n"); grid = -1; return; }
        hipOccupancyMaxActiveBlocksPerMultiprocessor(&per_cu, (const void*)fwd_megakernel, 512, LDS_BYTES);
        (void)hipGetLastError();
        if (per_cu < 1) { fprintf(stderr, "kernel_launch: occupancy query says %d blocks per CU\n", per_cu); grid = -1; return; }
        grid = cus;
        if (grid > 256) grid = 256;
    }
    if (grid < 0) return;
    hipMemsetAsync((char*)d_ws + WS_CTL, 0, CTL_BYTES, stream);
    Args a{};
    for (int i = 0; i < 16; ++i) a.in[i] = d_in[i];
    a.out = (float*)d_out; a.ws = (unsigned char*)d_ws;
#if N_LAUNCH_SPLIT
    for (int p = 0; p < N_PHASES; ++p) { a.ph_lo = p; a.ph_hi = p + 1; hipLaunchKernelGGL(fwd_megakernel, dim3(grid), dim3(512), LDS_BYTES, stream, a); }
#else
    a.ph_lo = 0; a.ph_hi = N_PHASES;
    void* kargs[] = {&a};
    hipError_t e = hipLaunchCooperativeKernel((const void*)fwd_megakernel, dim3(grid), dim3(512), kargs, LDS_BYTES, stream);
    if (e != hipSuccess) fprintf(stderr, "kernel_launch: cooperative launch failed: %s (grid %d)\n", hipGetErrorString(e), grid);
#endif
}
```

```cpp
#include <hip/hip_runtime.h>
#include <hip/hip_bf16.h>
#include <cstdio>
#include <cstdint>

#ifndef DBG
#define DBG 0
#endif
#define NO_SSQ_TEST 0
#define REP4 1
#define REPMASK 0x0
#ifndef N_LAUNCH_SPLIT
#define N_LAUNCH_SPLIT 0
#endif

#define LAS __attribute__((address_space(3)))
#define GAS __attribute__((address_space(1)))
typedef unsigned short bf16_t;
typedef short bf16x8 __attribute__((ext_vector_type(8)));
typedef short s16x4 __attribute__((ext_vector_type(4)));
typedef float f32x4 __attribute__((ext_vector_type(4)));
typedef float f32x2 __attribute__((ext_vector_type(2)));
typedef float f32x16 __attribute__((ext_vector_type(16)));
typedef unsigned u32x4 __attribute__((ext_vector_type(4)));
typedef unsigned u32x2 __attribute__((ext_vector_type(2)));

constexpr int T = 8192, SEQ = 4096, DM = 2048, DFF = 8192;
constexpr int N_IN = 11328, N1P = 11520;
constexpr float EPS = 1e-6f;
constexpr float C2Q = 0.07216878364870322f * 1.4426950408889634f;
constexpr float RK_SCALE = 0.08838834764831845f;
constexpr int LO_RQ = 0, LO_RK = 1024, LO_RV = 2048, LO_RG = 4096, LO_CQ = 6144, LO_CKV = 6656, LO_KPE = 7168, LO_GRET = 7232, LO_GMLA = 9280;

constexpr size_t MiB = 1u << 20;
constexpr size_t WS_CTL = 0, CTL_BYTES = 1 * MiB;
constexpr size_t WS_WRM = 1 * MiB, WS_WO = 17 * MiB, WS_WQ = 25 * MiB, WS_WKV = 28 * MiB;
constexpr size_t WS_RC64 = 32 * MiB, WS_RS64 = 34 * MiB, WS_RC32 = 36 * MiB, WS_RS32 = 37 * MiB;
constexpr size_t WS_WI = 38 * MiB, WS_U = 83 * MiB, WS_KVL = 38 * MiB, WS_RYMY = 38 * MiB, WS_H1B = 38 * MiB;
constexpr size_t WS_RQ = 115 * MiB, WS_RK = 131 * MiB, WS_RV = 147 * MiB, WS_SG = 179 * MiB, WS_KPE = 211 * MiB, WS_CQ = 212 * MiB, WS_CKV = 220 * MiB, WS_S = 212 * MiB;
constexpr size_t WS_QN = 228 * MiB, WS_QP = 260 * MiB, WS_KN = 276 * MiB, WS_V = 308 * MiB;
constexpr size_t WS_MERGED = 115 * MiB, WS_WU = 147 * MiB, WS_WD = 179 * MiB, WS_HMID = 211 * MiB;
constexpr size_t WS_END = 340 * MiB;
constexpr int CW_ERR = 0, CW_BAR = 1024;
constexpr size_t CTL_SSQ_Q = 64 * 1024, CTL_SSQ_KV = 96 * 1024, CTL_SSQ_H1 = 128 * 1024, CTL_SSQ_H2 = 160 * 1024;

constexpr int RING_BYTES = 131072, MISC_OFF = RING_BYTES + 320, LDS_BYTES = 147456;

typedef __bf16 bf16x2_t __attribute__((ext_vector_type(2)));
__device__ __forceinline__ unsigned cvt_pk_bf16(float lo, float hi) { f32x2 v = {lo, hi}; bf16x2_t b = __builtin_convertvector(v, bf16x2_t); return __builtin_bit_cast(unsigned, b); }
__device__ __forceinline__ float bf2f(bf16_t b) { return __uint_as_float(((unsigned)b) << 16); }
__device__ __forceinline__ float bflo(unsigned w) { return __uint_as_float(w << 16); }
__device__ __forceinline__ float bfhi(unsigned w) { return __uint_as_float(w & 0xffff0000u); }
__device__ __forceinline__ float wave_sum(float v) {
#pragma unroll
    for (int o = 1; o < 64; o <<= 1) v += __shfl_xor(v, o);
    return v;
}
__device__ __forceinline__ float fast_exp2(float x) { return __builtin_amdgcn_exp2f(x); }
__device__ __forceinline__ float fast_rcp(float x) { return __builtin_amdgcn_rcpf(x); }
__device__ __forceinline__ float sigmoidf_(float x) { return fast_rcp(1.0f + fast_exp2(-1.4426950408889634f * x)); }
__device__ __forceinline__ float log2gamma(int h) { return __log2f(1.0f - exp2f(-5.0f - (float)h)); }
#define LDS_WAIT() asm volatile("s_waitcnt lgkmcnt(0)" ::: "memory")
#define VM_WAIT() asm volatile("s_waitcnt vmcnt(0)" ::: "memory")
#define SBAR() __builtin_amdgcn_sched_barrier(0)

#define XB_TMO      128
#define XB_XCNT(j)  (256  + 64 * (j))
#define XB_XSUB(j)  (1280 + 64 * (j))
#define XB_XGEN(j)  (2304 + 64 * (j))
#define XB_TOP      3328
#define XB_TOPGEN   3392
#define XCD_BAR_WORDS 3456
#define XB_SPIN_CAP (1u << 18)
__device__ __forceinline__ unsigned xb_ld(unsigned* p)              { return __hip_atomic_load(p, __ATOMIC_RELAXED, __HIP_MEMORY_SCOPE_AGENT); }
__device__ __forceinline__ unsigned xb_add(unsigned* p, unsigned v) { return __hip_atomic_fetch_add(p, v, __ATOMIC_RELAXED, __HIP_MEMORY_SCOPE_AGENT); }
__device__ __forceinline__ unsigned xb_xcc_id() { return (unsigned)__builtin_amdgcn_s_getreg((3 << 11) | 20) & 0xFu; }
#define XB_SPIN(cond, bar) do { unsigned _sp = 0; while (cond) { __builtin_amdgcn_s_sleep(1); \
    if ((++_sp & 255u) == 0u) { if (xb_ld(&(bar)[XB_TMO])) break; if (_sp > XB_SPIN_CAP) { atomicAdd(&(bar)[XB_TMO], 1u); break; } } } } while (0)
struct XcdBarrier { unsigned* bar; unsigned x; volatile LAS unsigned* st; };
__device__ __forceinline__ XcdBarrier xcd_barrier_post(unsigned* bar, volatile LAS unsigned* st) {
    XcdBarrier b; b.bar = bar; b.x = xb_xcc_id(); b.st = st;
    if (threadIdx.x == 0) (void)xb_add(&bar[XB_XCNT(b.x)], 1u);
    return b;
}
__device__ __forceinline__ void xcd_barrier_complete(unsigned* bar, unsigned x, unsigned& nloc, unsigned& nx) {
    const unsigned G = gridDim.x * gridDim.y * gridDim.z;
    unsigned sum, cnt, mine, sp = 0u;
    for (;;) {
        sum = 0u; cnt = 0u; mine = 0u;
#pragma unroll
        for (unsigned j = 0; j < 16; ++j) { const unsigned c = xb_ld(&bar[XB_XCNT(j)]); sum += c; cnt += (c > 0u) ? 1u : 0u; mine = (j == x) ? c : mine; }
        if (sum == G) break;
        __builtin_amdgcn_s_sleep(1);
        if ((++sp & 255u) == 0u) { if (xb_ld(&bar[XB_TMO])) break; if (sp > XB_SPIN_CAP) { atomicAdd(&bar[XB_TMO], 1u); break; } }
    }
    nloc = mine > 0u ? mine : 1u; nx = cnt > 0u ? cnt : 1u;
}
__device__ __forceinline__ void xcd_barrier(const XcdBarrier& b) {
    asm volatile("s_waitcnt vmcnt(0)" ::: "memory");
    __syncthreads();
    if (threadIdx.x == 0) {
        unsigned* bar = b.bar;
        __builtin_amdgcn_s_waitcnt(0);
        unsigned nloc = b.st[0], nx = b.st[1];
        if (nloc == 0u) { xcd_barrier_complete(bar, b.x, nloc, nx); b.st[0] = nloc; b.st[1] = nx; }
        const unsigned old = xb_add(&bar[XB_XSUB(b.x)], 1u);
        const unsigned gen = old / nloc;
        if (old + 1u == (gen + 1u) * nloc) {
            __builtin_amdgcn_fence(__ATOMIC_RELEASE, "agent");
            asm volatile("s_waitcnt vmcnt(0)" ::: "memory");
            const unsigned og = xb_add(&bar[XB_TOP], 1u);
            const unsigned tg = og / nx;
            if (og + 1u == (tg + 1u) * nx) xb_add(&bar[XB_TOPGEN], 1u);
            else XB_SPIN(xb_ld(&bar[XB_TOPGEN]) == tg, bar);
            __builtin_amdgcn_fence(__ATOMIC_ACQUIRE, "agent");
            xb_add(&bar[XB_XGEN(b.x)], 1u);
            asm volatile("s_waitcnt vmcnt(0)" ::: "memory");
        } else {
            XB_SPIN(xb_ld(&bar[XB_XGEN(b.x)]) == gen, bar);
            __builtin_amdgcn_fence(__ATOMIC_ACQUIRE, "agent");
            asm volatile("s_waitcnt vmcnt(0)" ::: "memory");
        }
    }
    __syncthreads();
}

namespace pg8 {
constexpr int BM = 256, BK = 64, HALF = 128, HTB = HALF * BK * 2, STAGE_BYTES = 8 * HTB, NXCD = 8, WGM = 8;
__host__ __device__ __forceinline__ int lds_byte(int r, int c) { const int st = (r >> 4) * 2 + (c >> 5), rr = r & 15, cc = c & 31, ob = rr * 64 + cc * 2; return st * 1024 + (ob ^ (((ob >> 9) & 1) << 5)); }
__host__ __device__ __forceinline__ void stage_rc(int b, int& R, int& C) { const int st = b / 1024, sb = b % 1024, swz = sb ^ (((sb >> 9) & 1) << 5); R = (st >> 1) * 16 + swz / 64; C = (st & 1) * 32 + (swz % 64) / 2; }

struct Unit { int pm, pn, seg; };
__device__ __forceinline__ bool tile_order(int L, int nM, int nN, int& pm, int& pn) {
    const int nwg = nM * nN; if (L >= nwg) return false;
    int wgid = L; { const int q = nwg / NXCD, r = nwg % NXCD, xcd = wgid % NXCD, off = wgid / NXCD; wgid = (xcd < r ? xcd * (q + 1) : r * (q + 1) + (xcd - r) * q) + off; }
    const int nig = WGM * nN, gid = wgid / nig, fm = gid * WGM, gsz = (nM - fm) < WGM ? (nM - fm) : WGM;
    pm = fm + ((wgid % nig) % gsz); pn = (wgid % nig) / gsz; return true;
}

template <class Epi, class Sched, bool ALIGN_EPI>
__device__ __forceinline__ void gemm_phase(LAS unsigned char* lds, const int lda, const int ldb, const int nt, const Sched& S, const Epi& E) {
    const int tid = threadIdx.x, wid = __builtin_amdgcn_readfirstlane(tid >> 6), lane = tid & 63, wr = wid >> 2, wc = wid & 3, fr = lane & 15, fq = lane >> 4;
    unsigned voffA[2], voffB[2];
#pragma unroll
    for (int i = 0; i < 2; ++i) { int R, C; stage_rc(tid * 16 + i * 8192, R, C); voffA[i] = (unsigned)(R * lda + C) * 2u; voffB[i] = (unsigned)(R * ldb + C) * 2u; }
    const size_t kstep = (size_t)(BK * 2);
    const size_t hstepA = (size_t)HALF * lda * 2, hstepB = (size_t)HALF * ldb * 2;
    const unsigned ldsw = (unsigned)wid * 1024u;
    const int aoff = lds_byte(wr * 64 + fr, fq * 8), boff = lds_byte(wc * 32 + fr, fq * 8);
#define PG8_SA(b, h) (((b) * 2 + (h)) * HTB)
#define PG8_SB(b, h) ((4 + (b) * 2 + (h)) * HTB)
#define PG8_STAGE(bufoff, gbase, voff) do { _Pragma("unroll") for (int _i = 0; _i < 2; ++_i) \
        __builtin_amdgcn_global_load_lds((const unsigned*)((const char*)(gbase) + (voff)[_i]), (LAS unsigned*)(lds + (bufoff) + ldsw + _i * 8192), 16, 0, 0); } while (0)
#define PG8_LDA(dst, b, h) do { _Pragma("unroll") for (int m = 0; m < 4; ++m) _Pragma("unroll") for (int k = 0; k < 2; ++k) dst[m][k] = *(const LAS bf16x8*)(lds + PG8_SA(b, h) + aoff + m * 2048 + k * 1024); } while (0)
#define PG8_LDB(dst, b, h) do { _Pragma("unroll") for (int n = 0; n < 2; ++n) _Pragma("unroll") for (int k = 0; k < 2; ++k) dst[n][k] = *(const LAS bf16x8*)(lds + PG8_SB(b, h) + boff + n * 2048 + k * 1024); } while (0)
#define PG8_MMA(ai, bj, At, Bt) do { __builtin_amdgcn_s_setprio(1); _Pragma("unroll") for (int m = 0; m < 4; ++m) _Pragma("unroll") for (int n = 0; n < 2; ++n) _Pragma("unroll") for (int k = 0; k < 2; ++k) \
        acc[ai][bj][m][n] = __builtin_amdgcn_mfma_f32_16x16x32_bf16(Bt[n][k], At[m][k], acc[ai][bj][m][n], 0, 0, 0); __builtin_amdgcn_s_setprio(0); } while (0)
#define PG8_WAIT_V(n) asm volatile("s_waitcnt vmcnt(" #n ")" ::: "memory")
#define PG8_WAIT_L(n) asm volatile("s_waitcnt lgkmcnt(" #n ")" ::: "memory")
#define PG8_BAR __builtin_amdgcn_s_barrier()
#define PG8_SCHED __builtin_amdgcn_sched_barrier(0)
    Unit cur, nxt; int ui = 0;
    if (!S.next(0, cur)) return;
    f32x4 acc[2][2][4][2];
#pragma unroll
    for (int a = 0; a < 2; ++a)
#pragma unroll
        for (int b = 0; b < 2; ++b)
#pragma unroll
            for (int m = 0; m < 4; ++m)
#pragma unroll
                for (int n = 0; n < 2; ++n) acc[a][b][m][n] = (f32x4){0.f, 0.f, 0.f, 0.f};
    bf16x8 At[4][2], B0[2][2], B1[2][2];
    const char* cA; const char* cB; S.bases(cur, cA, cB);
    PG8_STAGE(PG8_SB(0, 0), cB, voffB); PG8_STAGE(PG8_SB(0, 1), cB + hstepB, voffB); PG8_STAGE(PG8_SA(0, 0), cA, voffA); PG8_STAGE(PG8_SA(0, 1), cA + hstepA, voffA);
    if (wr == 1) PG8_BAR;
    PG8_WAIT_V(2); PG8_BAR;
    PG8_STAGE(PG8_SB(1, 0), cB + kstep, voffB); PG8_STAGE(PG8_SA(1, 0), cA + kstep, voffA); PG8_STAGE(PG8_SB(1, 1), cB + hstepB + kstep, voffB);
    PG8_WAIT_V(6); PG8_BAR;
    for (;;) {
        const bool has_next = S.next(ui + 1, nxt);
        const char* nA = cA; const char* nB = cB; if (has_next) S.bases(nxt, nA, nB);
        for (int t = 0; t < nt; t += 2) {
            const bool last = (t == nt - 2);
            const char* a1 = cA + (size_t)(t + 1) * kstep;
            const char* a2 = last ? nA : cA + (size_t)(t + 2) * kstep; const char* b2 = last ? nB : cB + (size_t)(t + 2) * kstep;
            const char* a3 = a2 + kstep; const char* b3 = b2 + kstep;
            PG8_LDB(B0, 0, 0); PG8_LDB(B1, 0, 1); PG8_SCHED; PG8_LDA(At, 0, 0); PG8_STAGE(PG8_SA(1, 1), a1 + hstepA, voffA);
            PG8_WAIT_V(8); PG8_WAIT_L(0); PG8_BAR; PG8_MMA(0, 0, At, B0); PG8_MMA(0, 1, At, B1); PG8_BAR; PG8_SCHED;
            PG8_LDA(At, 0, 1); PG8_STAGE(PG8_SB(0, 0), b2, voffB); PG8_STAGE(PG8_SB(0, 1), b2 + hstepB, voffB); PG8_STAGE(PG8_SA(0, 0), a2, voffA);
            PG8_WAIT_V(8); PG8_WAIT_L(0); PG8_BAR; PG8_MMA(1, 0, At, B0); PG8_MMA(1, 1, At, B1); PG8_BAR; PG8_SCHED;
            PG8_LDB(B0, 1, 0); PG8_LDB(B1, 1, 1); PG8_SCHED; PG8_LDA(At, 1, 0); PG8_STAGE(PG8_SA(0, 1), a2 + hstepA, voffA);
            PG8_WAIT_V(8); PG8_WAIT_L(0); PG8_BAR; PG8_MMA(0, 0, At, B0); PG8_MMA(0, 1, At, B1); PG8_BAR; PG8_SCHED;
            PG8_LDA(At, 1, 1); PG8_STAGE(PG8_SB(1, 0), b3, voffB); PG8_STAGE(PG8_SB(1, 1), b3 + hstepB, voffB); PG8_STAGE(PG8_SA(1, 0), a3, voffA);
            PG8_WAIT_V(8); PG8_WAIT_L(0); PG8_BAR; PG8_MMA(1, 0, At, B0); PG8_MMA(1, 1, At, B1); PG8_BAR; PG8_SCHED;
        }
        if constexpr (ALIGN_EPI) { if (wr == 0) PG8_BAR; }
        const bool zero = E(acc, cur, wr, wc, fr, fq);
        if (!has_next) break;
        if (zero) {
#pragma unroll
            for (int a = 0; a < 2; ++a)
#pragma unroll
                for (int b = 0; b < 2; ++b)
#pragma unroll
                    for (int m = 0; m < 4; ++m)
#pragma unroll
                        for (int n = 0; n < 2; ++n) acc[a][b][m][n] = (f32x4){0.f, 0.f, 0.f, 0.f};
        }
        cur = nxt; cA = nA; cB = nB; ++ui;
        if constexpr (ALIGN_EPI) { if (wr == 1) PG8_BAR; }
    }
    PG8_WAIT_V(0);
    if constexpr (!ALIGN_EPI) { if (wr == 0) PG8_BAR; }
    PG8_BAR;
#undef PG8_SA
#undef PG8_SB
#undef PG8_STAGE
#undef PG8_LDA
#undef PG8_LDB
#undef PG8_MMA
#undef PG8_WAIT_V
#undef PG8_WAIT_L
#undef PG8_BAR
#undef PG8_SCHED
}
}

__device__ __forceinline__ int opaque_tid() { int t = (int)threadIdx.x; asm volatile("" : "+v"(t)); return t; }
#define F_TID ((int)threadIdx.x)
#define F_LANE ((int)threadIdx.x & 63)
#define F_WAVE (__builtin_amdgcn_readfirstlane((int)threadIdx.x >> 6))
struct Frame {
    LAS unsigned char* lds;
    int G, vcu;
    unsigned char* ws; float* out;
    const float* x; const int* pos; const float* g_mix; const float* w_in; const float* g_ret; const float* w_ret_o; const float* g_qa; const float* w_q_b;
    const float* g_kva; const float* w_kv_b; const float* w_mla_o; const float* w_out; const float* g_mlp; const float* w_up; const float* w_down; const float* g_f;
};
#define WSP(T_, off) ((T_*)(F.ws + (off)))

__device__ __forceinline__ int nat32(int c) { const int n = (c >> 4) & 1, fq = (c >> 2) & 3, e = c & 3; return (c & ~31) | (8 * fq + 4 * n + e); }
__device__ __forceinline__ int rope128(int c) { const int wc = (c >> 5) & 3, n = (c >> 4) & 1, fq = (c >> 2) & 3, e = c & 3; return (c & ~127) | (64 * n + 16 * wc + 4 * fq + e); }
__device__ __forceinline__ int rope64(int c) { const int wl = (c >> 5) & 1, n = (c >> 4) & 1, fq = (c >> 2) & 3, e = c & 3; return (c & ~63) | (32 * n + 16 * wl + 4 * fq + e); }
enum { MAP_NAT = 0, MAP_G1 = 1, MAP_Q = 2, MAP_KV = 3 };
template <int MAP> __device__ __forceinline__ int lcmap(int c) {
    if (MAP == MAP_NAT) return nat32(c);
    if (MAP == MAP_G1) {
        const int t = c >> 8;
        if (t < 4) return LO_RQ + rope128(c);
        if (t < 8) return LO_RK + rope128(c - 1024);
        if (t < 16) return LO_RV + nat32(c - 2048);
        if (t < 24) return LO_RG + nat32(c - 4096);
        if (t < 26) return LO_CQ + nat32(c - 6144);
        if (t < 28) return LO_CKV + nat32(c - 6656);
        if (t < 36) return LO_GRET + nat32(c - 7168);
        if (t < 44) return LO_GMLA + nat32(c - 9216);
        const int cc = c - 11264; return cc < 64 ? LO_KPE + rope64(cc) : -1;
    }
    if (MAP == MAP_Q) {
        if (c < 2048) { const int l = nat32(c); return (l >> 7) * 192 + (l & 127); }
        const int cc = c - 2048, l = rope64(cc); return (l >> 6) * 192 + 128 + (l & 63);
    }
    { const int part = c >> 11, l = nat32(c & 2047); return (l >> 7) * 256 + part * 128 + (l & 127); }
}
template <int MAP>
__device__ __forceinline__ void cvt_item(const float* W, int Nsrc, bf16_t* Wt, int ldw, int koff, int nblk, const float* gain, LAS float* scr, int item, int lane) {
    const int kb = item / nblk, nb = item % nblk, k0 = 64 * kb, n0 = 32 * nb;
    const int kq = lane >> 3, pc = lane & 7;
    const int lc = lcmap<MAP>(n0 + 4 * pc);
    f32x4 v[8];
#pragma unroll
    for (int i = 0; i < 8; ++i) { v[i] = (f32x4){0.f, 0.f, 0.f, 0.f}; if (lc >= 0) v[i] = __builtin_nontemporal_load((const f32x4*)(W + (size_t)(k0 + 8 * i + kq) * Nsrc + lc)); }
    if (gain) {
#pragma unroll
        for (int i = 0; i < 8; ++i) v[i] = v[i] * gain[k0 + 8 * i + kq]; }
#pragma unroll
    for (int i = 0; i < 8; ++i)
#pragma unroll
        for (int e = 0; e < 4; ++e) scr[(4 * pc + e) * 68 + 8 * i + kq] = v[i][e];
    LDS_WAIT(); asm volatile("" ::: "memory");
    const int c = lane & 7;
#pragma unroll
    for (int j = 0; j < 4; ++j) { const int n = (lane >> 3) + 8 * j; const LAS f32x4* sp = (const LAS f32x4*)(scr + n * 68 + 8 * c); const f32x4 a = sp[0], bq = sp[1];
        u32x4 o; o.x = cvt_pk_bf16(a[0], a[1]); o.y = cvt_pk_bf16(a[2], a[3]); o.z = cvt_pk_bf16(bq[0], bq[1]); o.w = cvt_pk_bf16(bq[2], bq[3]);
        *(u32x4*)(Wt + (size_t)(n0 + n) * ldw + koff + k0 + 8 * c) = o; }
    LDS_WAIT(); asm volatile("" ::: "memory");
}
__device__ __forceinline__ void sincos_acc(float ang, float& s, float& c) {
    const double a = (double)ang; const double k = rint(a * 0.63661977236758134308);
    const double r = fma(-k, 1.57079632679489661923, a) - k * 6.123233995736766e-17;
    const double r2 = r * r;
    const double sp = r * (1.0 + r2 * (-1.0 / 6 + r2 * (1.0 / 120 + r2 * (-1.0 / 5040 + r2 * (1.0 / 362880 + r2 * (-1.0 / 39916800))))));
    const double cp = 1.0 + r2 * (-0.5 + r2 * (1.0 / 24 + r2 * (-1.0 / 720 + r2 * (1.0 / 40320 + r2 * (-1.0 / 3628800 + r2 * (1.0 / 479001600))))));
    const int q = ((int)k) & 3;
    const double ss = (q & 1) ? cp : sp, cc = (q & 1) ? sp : cp;
    s = (float)((q & 2) ? -ss : ss); c = (float)(((q + 1) & 2) ? -cc : cc);
}
__device__ __forceinline__ void p0_prologue(Frame& F) {
    LAS float* scr = (LAS float*)(F.lds + F_WAVE * 16384);
    const int gw = F.vcu * 8 + F_WAVE, NGW = F.G * 8;
    constexpr int I_WI = 32 * (N1P / 32), I_WQ = 8 * 96, I_WKV = 8 * 128, I_WR = 32 * 64, I_WM = 32 * 64, I_WO = 32 * 64;
    constexpr int NITEMS = I_WI + I_WQ + I_WKV + I_WR + I_WM + I_WO;
    for (int it = gw; it < NITEMS; it += NGW) {
        int r = it;
        if (r < I_WI) { cvt_item<MAP_G1>(F.w_in, N_IN, WSP(bf16_t, WS_WI), 2048, 0, N1P / 32, nullptr, scr, r, F_LANE); continue; } r -= I_WI;
        if (r < I_WQ) { cvt_item<MAP_Q>(F.w_q_b, 3072, WSP(bf16_t, WS_WQ), 512, 0, 96, F.g_qa, scr, r, F_LANE); continue; } r -= I_WQ;
        if (r < I_WKV) { cvt_item<MAP_KV>(F.w_kv_b, 4096, WSP(bf16_t, WS_WKV), 512, 0, 128, F.g_kva, scr, r, F_LANE); continue; } r -= I_WKV;
        if (r < I_WR) { cvt_item<MAP_NAT>(F.w_ret_o, 2048, WSP(bf16_t, WS_WRM), 4096, 0, 64, nullptr, scr, r, F_LANE); continue; } r -= I_WR;
        if (r < I_WM) { cvt_item<MAP_NAT>(F.w_mla_o, 2048, WSP(bf16_t, WS_WRM), 4096, 2048, 64, nullptr, scr, r, F_LANE); continue; } r -= I_WM;
        cvt_item<MAP_NAT>(F.w_out, 2048, WSP(bf16_t, WS_WO), 2048, 0, 64, nullptr, scr, r, F_LANE);
    }
    bf16_t* U = WSP(bf16_t, WS_U);
    for (int m = gw; m < T; m += NGW) {
        const f32x4* xr = (const f32x4*)(F.x + (size_t)m * DM) + F_LANE; const f32x4* gr = (const f32x4*)F.g_mix + F_LANE;
        f32x4 v[8]; float s = 0.f;
#pragma unroll
        for (int j = 0; j < 8; ++j) { v[j] = xr[64 * j]; s += (v[j].x * v[j].x + v[j].y * v[j].y) + (v[j].z * v[j].z + v[j].w * v[j].w); }
        const float rinv = 1.0f / sqrtf(wave_sum(s) * (1.f / DM) + EPS);
        u32x2* o8 = (u32x2*)(U + (size_t)m * DM) + F_LANE;
#pragma unroll
        for (int j = 0; j < 8; ++j) { const f32x4 g = gr[64 * j]; u32x2 w; w.x = cvt_pk_bf16(v[j].x * rinv * g.x, v[j].y * rinv * g.y); w.y = cvt_pk_bf16(v[j].z * rinv * g.z, v[j].w * rinv * g.w); o8[64 * j] = w; }
    }
    float* rc64 = WSP(float, WS_RC64); float* rs64 = WSP(float, WS_RS64); float* rc32 = WSP(float, WS_RC32); float* rs32 = WSP(float, WS_RS32);
    const int gt = (F.vcu * 8 + F_WAVE) * 64 + F_LANE, NGT = F.G * 512;
    for (int i = gt; i < T * 64; i += NGT) { const int t = i >> 6, j = i & 63; const float inv = powf(10000.0f, -(float)j / 64.0f); const float ang = (float)F.pos[t] * inv; float s, c; sincos_acc(ang, s, c); rc64[i] = c; rs64[i] = s; }
    for (int i = gt; i < T * 32; i += NGT) { const int t = i >> 5, j = i & 31; const float inv = powf(10000.0f, -(float)j / 32.0f); const float ang = (float)F.pos[t] * inv; float s, c; sincos_acc(ang, s, c); rc32[i] = c; rs32[i] = s; }
}
__device__ __forceinline__ void p5_convert(Frame& F) {
    LAS float* scr = (LAS float*)(F.lds + F_WAVE * 16384);
    const int gw = F.vcu * 8 + F_WAVE, NGW = F.G * 8;
    constexpr int I_WU = 32 * 256, I_WD = 128 * 64;
    for (int it = gw; it < I_WU + I_WD; it += NGW) {
        if (it < I_WU) cvt_item<MAP_NAT>(F.w_up, 8192, WSP(bf16_t, WS_WU), 2048, 0, 256, F.g_mlp, scr, it, F_LANE);
        else cvt_item<MAP_NAT>(F.w_down, 2048, WSP(bf16_t, WS_WD), 8192, 0, 64, nullptr, scr, it - I_WU, F_LANE);
    }
}

typedef f32x4 Acc[2][2][4][2];
__device__ __forceinline__ u32x4 pack8(f32x4 a, f32x4 b) { u32x4 w; w.x = cvt_pk_bf16(a[0], a[1]); w.y = cvt_pk_bf16(a[2], a[3]); w.z = cvt_pk_bf16(b[0], b[1]); w.w = cvt_pk_bf16(b[2], b[3]); return w; }
template <int OP> __device__ __forceinline__ f32x4 act4(f32x4 v) {
    if (OP == 1) { f32x4 o; for (int i = 0; i < 4; ++i) o[i] = v[i] * sigmoidf_(v[i]); return o; }
    if (OP == 2) { f32x4 o; for (int i = 0; i < 4; ++i) o[i] = sigmoidf_(v[i]); return o; }
    if (OP == 3) { f32x4 o; for (int i = 0; i < 4; ++i) { const float r = fmaxf(v[i], 0.f); o[i] = r * r; } return o; }
    return v;
}
template <int OP, bool ROWSCALE>
__device__ __forceinline__ void store_tile_bf16(const Acc& acc, bf16_t* O, int ldc, int row0, int col0, const float* rs, float cs) {
#pragma unroll
    for (int ai = 0; ai < 2; ++ai)
#pragma unroll
        for (int m = 0; m < 4; ++m) { const int row = row0 + ai * 128 + m * 16; bf16_t* rowp = O + (size_t)row * ldc + col0; float sc = cs; if (ROWSCALE) sc *= rs[row];
#pragma unroll
            for (int bj = 0; bj < 2; ++bj) { const f32x4 v0 = act4<OP>(acc[ai][bj][m][0] * sc), v1 = act4<OP>(acc[ai][bj][m][1] * sc); *(u32x4*)(rowp + bj * 128) = pack8(v0, v1); } }
}
__device__ __forceinline__ void ssq_tile(const Acc& acc, float* ssq, int row0, int fq) {
#pragma unroll
    for (int ai = 0; ai < 2; ++ai)
#pragma unroll
        for (int m = 0; m < 4; ++m) { float s = 0.f;
#pragma unroll
            for (int bj = 0; bj < 2; ++bj)
#pragma unroll
                for (int n = 0; n < 2; ++n) { const f32x4 v = acc[ai][bj][m][n]; s += (v[0] * v[0] + v[1] * v[1]) + (v[2] * v[2] + v[3] * v[3]); }
            s += __shfl_xor(s, 16); s += __shfl_xor(s, 32);
            if (fq == 0) atomicAdd(ssq + row0 + ai * 128 + m * 16, s); }
}

struct SchedG1 {
    int G, c; const char* A; const char* B;
    __device__ __forceinline__ bool next(int i, pg8::Unit& u) const { u.seg = 0; return pg8::tile_order(i * G + c, T / 256, N1P / 256, u.pm, u.pn); }
    __device__ __forceinline__ void bases(const pg8::Unit& u, const char*& cA, const char*& cB) const { cA = A + (size_t)u.pm * 256 * 2048 * 2; cB = B + (size_t)u.pn * 256 * 2048 * 2; }
};
struct EpiG1 {
    bf16_t *RQ, *RK, *RV, *SG, *CQ, *CKV, *KPE, *SGR, *SGM; const float *rc64, *rs64, *rc32, *rs32; float *ssq_q, *ssq_kv;
    __device__ __forceinline__ bool operator()(const Acc& acc, const pg8::Unit& u, int wr, int wc, int fr, int fq) const {
        const int pn = u.pn, row0 = u.pm * 256 + wr * 64 + fr, cl = wc * 32 + 8 * fq;
        if (pn < 8) {
            bf16_t* O = pn < 4 ? RQ : RK; const float sc = pn < 4 ? 1.0f : RK_SCALE;
#pragma unroll
            for (int ai = 0; ai < 2; ++ai)
#pragma unroll
                for (int m = 0; m < 4; ++m) { const int row = row0 + ai * 128 + m * 16;
                    const f32x4 c = *(const f32x4*)(rc64 + (size_t)row * 64 + 16 * wc + 4 * fq) * sc, s = *(const f32x4*)(rs64 + (size_t)row * 64 + 16 * wc + 4 * fq) * sc;
#pragma unroll
                    for (int bj = 0; bj < 2; ++bj) { const f32x4 x1 = acc[ai][bj][m][0], x2 = acc[ai][bj][m][1];
                        *(u32x4*)(O + (size_t)row * 1024 + ((pn & 3) * 2 + bj) * 128 + cl) = pack8(x1 * c - x2 * s, x2 * c + x1 * s); } }
        } else if (pn < 16) store_tile_bf16<0, false>(acc, RV, 2048, row0, (pn - 8) * 256 + cl, nullptr, 1.f);
        else if (pn < 24) store_tile_bf16<1, false>(acc, SG, 2048, row0, (pn - 16) * 256 + cl, nullptr, 1.f);
        else if (pn < 26) { store_tile_bf16<0, false>(acc, CQ, 512, row0, (pn - 24) * 256 + cl, nullptr, 1.f); if (!NO_SSQ_TEST) ssq_tile(acc, ssq_q, row0, fq); }
        else if (pn < 28) { store_tile_bf16<0, false>(acc, CKV, 512, row0, (pn - 26) * 256 + cl, nullptr, 1.f); if (!NO_SSQ_TEST) ssq_tile(acc, ssq_kv, row0, fq); }
        else if (pn < 36) store_tile_bf16<2, false>(acc, SGR, 2048, row0, (pn - 28) * 256 + cl, nullptr, 1.f);
        else if (pn < 44) store_tile_bf16<2, false>(acc, SGM, 2048, row0, (pn - 36) * 256 + cl, nullptr, 1.f);
        else if (wc < 2) {
#pragma unroll
            for (int ai = 0; ai < 2; ++ai)
#pragma unroll
                for (int m = 0; m < 4; ++m) { const int row = row0 + ai * 128 + m * 16;
                    const f32x4 c = *(const f32x4*)(rc32 + (size_t)row * 32 + 16 * wc + 4 * fq), s = *(const f32x4*)(rs32 + (size_t)row * 32 + 16 * wc + 4 * fq);
                    const f32x4 x1 = acc[ai][0][m][0], x2 = acc[ai][0][m][1];
                    *(u32x4*)(KPE + (size_t)row * 64 + cl) = pack8(x1 * c - x2 * s, x2 * c + x1 * s); }
        }
        return true;
    }
};
struct SchedG2 {
    int G, c; const char *CQ, *CKV, *WQ, *WKV;
    __device__ __forceinline__ bool next(int i, pg8::Unit& u) const { u.seg = 0; return pg8::tile_order(i * G + c, T / 256, 28, u.pm, u.pn); }
    __device__ __forceinline__ void bases(const pg8::Unit& u, const char*& cA, const char*& cB) const {
        const bool q = u.pn < 12; cA = (q ? CQ : CKV) + (size_t)u.pm * 256 * 512 * 2; cB = q ? WQ + (size_t)u.pn * 256 * 512 * 2 : WKV + (size_t)(u.pn - 12) * 256 * 512 * 2; }
};
struct EpiG2 {
    bf16_t *QN, *QP, *KN, *V; const float *rc32, *rs32; const float *ssq_q, *ssq_kv;
    __device__ __forceinline__ bool operator()(const Acc& acc, const pg8::Unit& u, int wr, int wc, int fr, int fq) const {
        const int pn = u.pn, row0 = u.pm * 256 + wr * 64 + fr, cl = wc * 32 + 8 * fq;
        const float* ssq = pn < 12 ? ssq_q : ssq_kv; const float cs = pn < 12 ? C2Q : 1.0f;
        float rinv[2][4];
#pragma unroll
        for (int ai = 0; ai < 2; ++ai)
#pragma unroll
            for (int m = 0; m < 4; ++m) rinv[ai][m] = cs / sqrtf(__builtin_nontemporal_load(ssq + row0 + ai * 128 + m * 16) * (1.0f / 512.0f) + EPS);
        bf16_t* O; int colt;
        if (pn < 8) { O = QN; colt = pn * 256; } else if (pn < 12) { O = QP; colt = (pn - 8) * 256; } else if (pn < 20) { O = KN; colt = (pn - 12) * 256; } else { O = V; colt = (pn - 20) * 256; }
        const int ldc = (pn >= 8 && pn < 12) ? 1024 : 2048;
        const bool rope = (pn >= 8 && pn < 12);
#pragma unroll
        for (int ai = 0; ai < 2; ++ai)
#pragma unroll
            for (int m = 0; m < 4; ++m) { const int row = row0 + ai * 128 + m * 16; const float sc = rinv[ai][m];
                f32x4 c = (f32x4){sc, sc, sc, sc}, s = (f32x4){0.f, 0.f, 0.f, 0.f};
                if (rope) { c = *(const f32x4*)(rc32 + (size_t)row * 32 + 16 * (wc & 1) + 4 * fq) * sc; s = *(const f32x4*)(rs32 + (size_t)row * 32 + 16 * (wc & 1) + 4 * fq) * sc; }
#pragma unroll
                for (int bj = 0; bj < 2; ++bj) { const f32x4 x1 = acc[ai][bj][m][0], x2 = acc[ai][bj][m][1];
                    *(u32x4*)(O + (size_t)row * ldc + colt + bj * 128 + cl) = pack8(x1 * c - x2 * s, x2 * c + x1 * s); } }
        return true;
    }
};
struct SchedG5 {
    int G, c; const char *A, *B;
    __device__ __forceinline__ bool next(int i, pg8::Unit& u) const { u.seg = i & 1; return pg8::tile_order((i >> 1) * G + c, T / 256, 8, u.pm, u.pn); }
    __device__ __forceinline__ void bases(const pg8::Unit& u, const char*& cA, const char*& cB) const { cA = A + ((size_t)u.pm * 256 * 4096 + u.seg * 2048) * 2; cB = B + ((size_t)u.pn * 256 * 4096 + u.seg * 2048) * 2; }
};
struct EpiG5 {
    const bf16_t *SGR, *SGM; bf16_t* MERGED;
    __device__ __forceinline__ bool operator()(Acc& acc, const pg8::Unit& u, int wr, int wc, int fr, int fq) const {
        const int row0 = u.pm * 256 + wr * 64 + fr, col0 = u.pn * 256 + wc * 32 + 8 * fq;
#pragma unroll
        for (int ai = 0; ai < 2; ++ai)
#pragma unroll
            for (int m = 0; m < 4; ++m) { const size_t off = (size_t)(row0 + ai * 128 + m * 16) * 2048 + col0;
#pragma unroll
                for (int bj = 0; bj < 2; ++bj) {
                    const u32x4 gm = *(const u32x4*)(SGM + off + bj * 128);
                    const f32x4 m0 = (f32x4){bflo(gm.x), bfhi(gm.x), bflo(gm.y), bfhi(gm.y)}, m1 = (f32x4){bflo(gm.z), bfhi(gm.z), bflo(gm.w), bfhi(gm.w)};
                    if (u.seg == 0) {
                        const u32x4 gr = *(const u32x4*)(SGR + off + bj * 128);
                        const f32x4 r0 = (f32x4){bflo(gr.x), bfhi(gr.x), bflo(gr.y), bfhi(gr.y)}, r1 = (f32x4){bflo(gr.z), bfhi(gr.z), bflo(gr.w), bfhi(gr.w)};
#pragma unroll
                        for (int e = 0; e < 4; ++e) { acc[ai][bj][m][0][e] *= r0[e] * fast_rcp(fmaxf(m0[e], 1e-30f)); acc[ai][bj][m][1][e] *= r1[e] * fast_rcp(fmaxf(m1[e], 1e-30f)); }
                    } else *(u32x4*)(MERGED + off + bj * 128) = pack8(acc[ai][bj][m][0] * m0, acc[ai][bj][m][1] * m1);
                } }
        return u.seg != 0;
    }
};
struct SchedN {
    int G, c, nN; const char *A, *B; size_t astep, bstep;
    __device__ __forceinline__ bool next(int i, pg8::Unit& u) const { u.seg = 0; return pg8::tile_order(i * G + c, T / 256, nN, u.pm, u.pn); }
    __device__ __forceinline__ void bases(const pg8::Unit& u, const char*& cA, const char*& cB) const { cA = A + (size_t)u.pm * astep; cB = B + (size_t)u.pn * bstep; }
};
struct EpiG6 {
    const float* x; float* h1; bf16_t* H1B; float* ssq;
    __device__ __forceinline__ bool operator()(const Acc& acc, const pg8::Unit& u, int wr, int wc, int fr, int fq) const {
        const int row0 = u.pm * 256 + wr * 64 + fr, col0 = u.pn * 256 + wc * 32 + 8 * fq;
#pragma unroll
        for (int ai = 0; ai < 2; ++ai)
#pragma unroll
            for (int m = 0; m < 4; ++m) { const int row = row0 + ai * 128 + m * 16; const size_t off = (size_t)row * 2048 + col0; float s = 0.f;
#pragma unroll
                for (int bj = 0; bj < 2; ++bj) {
                    const f32x4 a = *(const f32x4*)(x + off + bj * 128) + acc[ai][bj][m][0], b = *(const f32x4*)(x + off + bj * 128 + 4) + acc[ai][bj][m][1];
                    *(f32x4*)(h1 + off + bj * 128) = a; *(f32x4*)(h1 + off + bj * 128 + 4) = b; *(u32x4*)(H1B + off + bj * 128) = pack8(a, b);
                    s += (a[0] * a[0] + a[1] * a[1]) + (a[2] * a[2] + a[3] * a[3]) + (b[0] * b[0] + b[1] * b[1]) + (b[2] * b[2] + b[3] * b[3]); }
                s += __shfl_xor(s, 16); s += __shfl_xor(s, 32);
                if (fq == 0) atomicAdd(ssq + row, s); }
        return true;
    }
};
struct EpiG7 {
    bf16_t* HMID; const float* ssq;
    __device__ __forceinline__ bool operator()(const Acc& acc, const pg8::Unit& u, int wr, int wc, int fr, int fq) const {
        const int row0 = u.pm * 256 + wr * 64 + fr, col0 = u.pn * 256 + wc * 32 + 8 * fq;
#pragma unroll
        for (int ai = 0; ai < 2; ++ai)
#pragma unroll
            for (int m = 0; m < 4; ++m) { const int row = row0 + ai * 128 + m * 16; const float sc = 1.0f / sqrtf(__builtin_nontemporal_load(ssq + row) * (1.0f / 2048.0f) + EPS);
#pragma unroll
                for (int bj = 0; bj < 2; ++bj) *(u32x4*)(HMID + (size_t)row * 8192 + col0 + bj * 128) = pack8(act4<3>(acc[ai][bj][m][0] * sc), act4<3>(acc[ai][bj][m][1] * sc)); }
        return true;
    }
};
struct EpiG8 {
    float* h; float* ssq;
    __device__ __forceinline__ bool operator()(const Acc& acc, const pg8::Unit& u, int wr, int wc, int fr, int fq) const {
        const int row0 = u.pm * 256 + wr * 64 + fr, col0 = u.pn * 256 + wc * 32 + 8 * fq;
#pragma unroll
        for (int ai = 0; ai < 2; ++ai)
#pragma unroll
            for (int m = 0; m < 4; ++m) { const int row = row0 + ai * 128 + m * 16; const size_t off = (size_t)row * 2048 + col0; float s = 0.f;
#pragma unroll
                for (int bj = 0; bj < 2; ++bj) {
                    const f32x4 a = *(const f32x4*)(h + off + bj * 128) + acc[ai][bj][m][0], b = *(const f32x4*)(h + off + bj * 128 + 4) + acc[ai][bj][m][1];
                    *(f32x4*)(h + off + bj * 128) = a; *(f32x4*)(h + off + bj * 128 + 4) = b;
                    s += (a[0] * a[0] + a[1] * a[1]) + (a[2] * a[2] + a[3] * a[3]) + (b[0] * b[0] + b[1] * b[1]) + (b[2] * b[2] + b[3] * b[3]); }
                s += __shfl_xor(s, 16); s += __shfl_xor(s, 32);
                if (fq == 0) atomicAdd(ssq + row, s); }
        return true;
    }
};

__device__ __forceinline__ int crow(int r, int hi) { return (r & 3) + 8 * (r >> 2) + 4 * hi; }
#define KSWZ(row, colB) ((row) * 256 + ((colB) ^ (((row) & 7) << 4)))
#define PSWZ(row, colB) ((row) * 128 + ((colB) ^ ((((row) >> 1) & 7) << 4)))
template <int NCB> __device__ __forceinline__ int v_st(int k, int c) { const int kk = (k & ~0xC) | ((k & 4) << 1) | ((k & 8) >> 1); return ((kk >> 3) * NCB + (c >> 5)) * 512 + ((kk & 7) * 32 + (c & 31)) * 2; }
__device__ __forceinline__ int v_rd_base(int lane) { return ((lane & 3) << 3) | (((lane >> 2) & 3) << 6) | (((lane >> 4) & 1) << 5) | (((lane >> 5) & 1) << 8); }
template <int NCB> constexpr int v_rd_off(int d0, int ks, int half) { return d0 * 512 + ks * (2 * NCB * 512) + half * (NCB * 512); }
template <int OFF> __device__ __forceinline__ s16x4 tr_read(int vb) { s16x4 r; asm volatile("ds_read_b64_tr_b16 %0, %1 offset:%2" : "=&v"(r) : "v"(vb), "i"(OFF) : "memory"); return r; }
#define PKF(L, H) (bf16x8){L[0], L[1], L[2], L[3], H[0], H[1], H[2], H[3]}
template <int NCB, int D0, int KS> __device__ __forceinline__ void tr_frag_issue(int vb, s16x4& lo, s16x4& hi) { lo = tr_read<v_rd_off<NCB>(D0, KS, 0)>(vb); hi = tr_read<v_rd_off<NCB>(D0, KS, 1)>(vb); }
__device__ __forceinline__ void p_to_frags(const f32x16& p0, const f32x16& p1, bf16x8& pa0, bf16x8& pa1, bf16x8& pa2, bf16x8& pa3) {
#define PK4(P, BASE, OUT) do { unsigned a0 = cvt_pk_bf16(P[BASE + 0], P[BASE + 1]), a1 = cvt_pk_bf16(P[BASE + 2], P[BASE + 3]);   \
    unsigned b0 = cvt_pk_bf16(P[BASE + 4], P[BASE + 5]), b1 = cvt_pk_bf16(P[BASE + 6], P[BASE + 7]);                              \
    auto r0 = __builtin_amdgcn_permlane32_swap(a0, b0, false, false); auto r1 = __builtin_amdgcn_permlane32_swap(a1, b1, false, false); \
    u32x4 w = {r0[0], r1[0], r0[1], r1[1]}; OUT = *reinterpret_cast<bf16x8*>(&w); } while (0)
    PK4(p0, 0, pa0); PK4(p0, 8, pa1); PK4(p1, 0, pa2); PK4(p1, 8, pa3);
#undef PK4
}
template <int NCB, int D0> __device__ __forceinline__ void pv_one(f32x16& od, int vb, bf16x8 pa0, bf16x8 pa1, bf16x8 pa2, bf16x8 pa3) {
    s16x4 l0, h0, l1, h1, l2, h2, l3, h3;
    tr_frag_issue<NCB, D0, 0>(vb, l0, h0); tr_frag_issue<NCB, D0, 1>(vb, l1, h1); tr_frag_issue<NCB, D0, 2>(vb, l2, h2); tr_frag_issue<NCB, D0, 3>(vb, l3, h3);
    asm volatile("s_waitcnt lgkmcnt(0)" ::: "memory"); SBAR();
    od = __builtin_amdgcn_mfma_f32_32x32x16_bf16(pa0, PKF(l0, h0), od, 0, 0, 0);
    od = __builtin_amdgcn_mfma_f32_32x32x16_bf16(pa1, PKF(l1, h1), od, 0, 0, 0);
    od = __builtin_amdgcn_mfma_f32_32x32x16_bf16(pa2, PKF(l2, h2), od, 0, 0, 0);
    od = __builtin_amdgcn_mfma_f32_32x32x16_bf16(pa3, PKF(l3, h3), od, 0, 0, 0);
}
__device__ __forceinline__ float half_sum32(float v) {
#pragma unroll
    for (int o = 1; o < 32; o <<= 1) v += __shfl_xor(v, o);
    return v;
}

__device__ __forceinline__ void ret_local_unit(Frame& F, int unit) {
    const int tid = opaque_tid(), lane = tid & 63, w = F_WAVE, r32 = lane & 31, hi = lane >> 5;
    const int bh = unit >> 4, sc = unit & 15, b = bh >> 3, h = bh & 7; const int t0 = b * SEQ + sc * 256;
    const bf16_t* RK = WSP(bf16_t, WS_RK); const bf16_t* RV = WSP(bf16_t, WS_RV); float* KVL = WSP(float, WS_KVL) + (size_t)unit * 32768;
    const float lg = log2gamma(h);
    char* lds = (char*)F.lds; const int lbase = (int)(uintptr_t)F.lds;
    f32x16 acc[4];
#pragma unroll
    for (int i = 0; i < 4; ++i) acc[i] = f32x16{};
    const int kvb = lbase + v_rd_base(lane), vvb = lbase + 16384 + v_rd_base(lane);
    for (int tt = 0; tt < 4; ++tt) {
#pragma unroll
        for (int i = 0; i < 2; ++i) { const int key = (tid >> 4) + 32 * i, c8 = (tid & 15) * 8; const int p = tt * 64 + key;
            const u32x4 kr = *(const u32x4*)(RK + (size_t)(t0 + p) * 1024 + h * 128 + c8); const float g = fast_exp2(lg * (float)(255 - p));
            u32x4 o; o.x = cvt_pk_bf16(bflo(kr.x) * g, bfhi(kr.x) * g); o.y = cvt_pk_bf16(bflo(kr.y) * g, bfhi(kr.y) * g); o.z = cvt_pk_bf16(bflo(kr.z) * g, bfhi(kr.z) * g); o.w = cvt_pk_bf16(bflo(kr.w) * g, bfhi(kr.w) * g);
            *(u32x4*)(lds + v_st<4>(key, c8)) = o; }
#pragma unroll
        for (int i = 0; i < 4; ++i) { const int key = (tid >> 5) + 16 * i, c8 = (tid & 31) * 8;
            *(u32x4*)(lds + 16384 + v_st<8>(key, c8)) = *(const u32x4*)(RV + (size_t)(t0 + tt * 64 + key) * 2048 + h * 256 + c8); }
        __syncthreads();
#define RL_STEP(KS) do { s16x4 bl, bh_, a0l, a0h, a1l, a1h, a2l, a2h, a3l, a3h; \
        tr_frag_issue<8, 0, KS>(vvb + w * 512, bl, bh_); \
        tr_frag_issue<4, 0, KS>(kvb, a0l, a0h); tr_frag_issue<4, 1, KS>(kvb, a1l, a1h); tr_frag_issue<4, 2, KS>(kvb, a2l, a2h); tr_frag_issue<4, 3, KS>(kvb, a3l, a3h); \
        asm volatile("s_waitcnt lgkmcnt(0)" ::: "memory"); SBAR(); \
        const bf16x8 bf = PKF(bl, bh_); \
        acc[0] = __builtin_amdgcn_mfma_f32_32x32x16_bf16(PKF(a0l, a0h), bf, acc[0], 0, 0, 0); acc[1] = __builtin_amdgcn_mfma_f32_32x32x16_bf16(PKF(a1l, a1h), bf, acc[1], 0, 0, 0); \
        acc[2] = __builtin_amdgcn_mfma_f32_32x32x16_bf16(PKF(a2l, a2h), bf, acc[2], 0, 0, 0); acc[3] = __builtin_amdgcn_mfma_f32_32x32x16_bf16(PKF(a3l, a3h), bf, acc[3], 0, 0, 0); } while (0)
        RL_STEP(0); RL_STEP(1); RL_STEP(2); RL_STEP(3);
#undef RL_STEP
        __syncthreads();
    }
#pragma unroll
    for (int db = 0; db < 4; ++db)
#pragma unroll
        for (int r = 0; r < 16; ++r) KVL[(size_t)(32 * db + crow(r, hi)) * 256 + 32 * w + r32] = acc[db][r];
}
__device__ __forceinline__ void ret_scan(Frame& F) {
    const int gt = (F.vcu * 8 + F_WAVE) * 64 + F_LANE;
    if (gt >= 16 * 128 * 64) return;
    const int bh = gt >> 13, rem = gt & 8191, dk = rem >> 6, c4 = (rem & 63) * 4; const int h = bh & 7;
    const float g256 = fast_exp2(log2gamma(h) * 256.0f);
    const float* KVL = WSP(float, WS_KVL) + (size_t)bh * 16 * 32768 + dk * 256 + c4; bf16_t* S = WSP(bf16_t, WS_S) + (size_t)bh * 16 * 32768;
    const int so = v_st<8>(dk, c4) / 2;
    f32x4 st = (f32x4){0.f, 0.f, 0.f, 0.f};
    f32x4 nx = *(const f32x4*)(KVL);
    for (int sc = 0; sc < 15; ++sc) {
        const f32x4 cur = nx; if (sc < 14) nx = *(const f32x4*)(KVL + (size_t)(sc + 1) * 32768);
        st = st * g256 + cur;
        u32x2 w; w.x = cvt_pk_bf16(st[0], st[1]); w.y = cvt_pk_bf16(st[2], st[3]);
        *(u32x2*)(S + (size_t)(sc + 1) * 32768 + so) = w;
    }
}
__device__ __forceinline__ void ret_out_unit(Frame& F, int unit) {
    const int tid = opaque_tid(), lane = tid & 63, w = F_WAVE, r32 = lane & 31, hi = lane >> 5;
    const int bh = unit >> 4, sc = unit & 15, b = bh >> 3, h = bh & 7; const int t0 = b * SEQ + sc * 256;
    const bf16_t* RQ = WSP(bf16_t, WS_RQ); const bf16_t* RK = WSP(bf16_t, WS_RK); const bf16_t* RV = WSP(bf16_t, WS_RV); const bf16_t* SG = WSP(bf16_t, WS_SG);
    const bf16_t* S = WSP(bf16_t, WS_S) + (size_t)unit * 32768; bf16_t* RY = WSP(bf16_t, WS_RYMY);
    const float lg = log2gamma(h);
    char* lds = (char*)F.lds; const int lbase = (int)(uintptr_t)F.lds;
    bf16x8 qr[8];
    { const bf16_t* qp = RQ + (size_t)(t0 + 32 * w + r32) * 1024 + h * 128 + hi * 8;
#pragma unroll
      for (int d0 = 0; d0 < 8; ++d0) qr[d0] = *(const bf16x8*)(qp + d0 * 16); }
    f32x16 o[8];
#pragma unroll
    for (int d = 0; d < 8; ++d) o[d] = f32x16{};
    if (sc > 0) {
#pragma unroll
        for (int i = 0; i < 8; ++i) *(u32x4*)(lds + (tid + 512 * i) * 16) = *(const u32x4*)((const char*)S + (tid + 512 * i) * 16);
        __syncthreads();
        const int svb = lbase + v_rd_base(lane);
#define QS_STEP(D0) do { s16x4 l0, h0, l1, h1, l2, h2, l3, h3; \
        tr_frag_issue<8, D0, 0>(svb, l0, h0); tr_frag_issue<8, D0, 1>(svb, l1, h1); tr_frag_issue<8, D0, 2>(svb, l2, h2); tr_frag_issue<8, D0, 3>(svb, l3, h3); \
        asm volatile("s_waitcnt lgkmcnt(0)" ::: "memory"); SBAR(); \
        o[D0] = __builtin_amdgcn_mfma_f32_32x32x16_bf16(qr[0], PKF(l0, h0), o[D0], 0, 0, 0); o[D0] = __builtin_amdgcn_mfma_f32_32x32x16_bf16(qr[1], PKF(l1, h1), o[D0], 0, 0, 0); \
        o[D0] = __builtin_amdgcn_mfma_f32_32x32x16_bf16(qr[2], PKF(l2, h2), o[D0], 0, 0, 0); o[D0] = __builtin_amdgcn_mfma_f32_32x32x16_bf16(qr[3], PKF(l3, h3), o[D0], 0, 0, 0); SBAR(); \
        tr_frag_issue<8, D0, 4>(svb, l0, h0); tr_frag_issue<8, D0, 5>(svb, l1, h1); tr_frag_issue<8, D0, 6>(svb, l2, h2); tr_frag_issue<8, D0, 7>(svb, l3, h3); \
        asm volatile("s_waitcnt lgkmcnt(0)" ::: "memory"); SBAR(); \
        o[D0] = __builtin_amdgcn_mfma_f32_32x32x16_bf16(qr[4], PKF(l0, h0), o[D0], 0, 0, 0); o[D0] = __builtin_amdgcn_mfma_f32_32x32x16_bf16(qr[5], PKF(l1, h1), o[D0], 0, 0, 0); \
        o[D0] = __builtin_amdgcn_mfma_f32_32x32x16_bf16(qr[6], PKF(l2, h2), o[D0], 0, 0, 0); o[D0] = __builtin_amdgcn_mfma_f32_32x32x16_bf16(qr[7], PKF(l3, h3), o[D0], 0, 0, 0); SBAR(); } while (0)
        QS_STEP(0); QS_STEP(1); QS_STEP(2); QS_STEP(3); QS_STEP(4); QS_STEP(5); QS_STEP(6); QS_STEP(7);
#undef QS_STEP
        float rbase = lg * (float)(32 * w + 4 * hi + 1); asm volatile("" : "+v"(rbase));
#pragma unroll
        for (int r = 0; r < 16; ++r) { const float g = fast_exp2(rbase + lg * (float)((r & 3) + 8 * (r >> 2)));
#pragma unroll
            for (int d = 0; d < 8; ++d) o[d][r] *= g; }
    }
    const int vvb = lbase + 81920 + v_rd_base(lane); const char* Kt = lds + 65536;
    const int nq = 32 * w + r32;
    for (int tt = 0; tt < 4; ++tt) {
#pragma unroll
        for (int i = 0; i < 2; ++i) { const int key = (tid >> 4) + 32 * i, c8 = (tid & 15) * 8;
            *(u32x4*)(lds + 65536 + KSWZ(key, c8 * 2)) = *(const u32x4*)(RK + (size_t)(t0 + tt * 64 + key) * 1024 + h * 128 + c8); }
#pragma unroll
        for (int i = 0; i < 4; ++i) { const int key = (tid >> 5) + 16 * i, c8 = (tid & 31) * 8;
            *(u32x4*)(lds + 81920 + v_st<8>(key, c8)) = *(const u32x4*)(RV + (size_t)(t0 + tt * 64 + key) * 2048 + h * 256 + c8); }
        __syncthreads();
        if (tt <= (w >> 1)) {
            f32x16 p0 = f32x16{}, p1 = f32x16{};
            { const bf16_t* qp2 = RQ + (size_t)(t0 + 32 * w + r32) * 1024 + h * 128 + hi * 8; asm volatile("" : "+v"(qp2));
#pragma unroll
              for (int d0 = 0; d0 < 8; ++d0) qr[d0] = *(const bf16x8*)(qp2 + d0 * 16); }
#pragma unroll
            for (int d0 = 0; d0 < 8; ++d0) { const int cb = (d0 * 16 + hi * 8) * 2;
                const bf16x8 k0 = *(const bf16x8*)(Kt + KSWZ(r32, cb)), k1 = *(const bf16x8*)(Kt + KSWZ(32 + r32, cb));
                p0 = __builtin_amdgcn_mfma_f32_32x32x16_bf16(k0, qr[d0], p0, 0, 0, 0); p1 = __builtin_amdgcn_mfma_f32_32x32x16_bf16(k1, qr[d0], p1, 0, 0, 0); }
            float dbase = (float)(nq - tt * 64 - 4 * hi); asm volatile("" : "+v"(dbase));
#pragma unroll
            for (int r = 0; r < 16; ++r) { const float dd = dbase - (float)((r & 3) + 8 * (r >> 2));
                p0[r] *= fast_exp2(lg * fabsf(dd)); p1[r] *= fast_exp2(lg * fabsf(dd - 32.f)); }
            bf16x8 pa0, pa1, pa2, pa3; p_to_frags(p0, p1, pa0, pa1, pa2, pa3);
            pv_one<8, 0>(o[0], vvb, pa0, pa1, pa2, pa3); pv_one<8, 1>(o[1], vvb, pa0, pa1, pa2, pa3); pv_one<8, 2>(o[2], vvb, pa0, pa1, pa2, pa3); pv_one<8, 3>(o[3], vvb, pa0, pa1, pa2, pa3);
            pv_one<8, 4>(o[4], vvb, pa0, pa1, pa2, pa3); pv_one<8, 5>(o[5], vvb, pa0, pa1, pa2, pa3); pv_one<8, 6>(o[6], vvb, pa0, pa1, pa2, pa3); pv_one<8, 7>(o[7], vvb, pa0, pa1, pa2, pa3);
        }
        __syncthreads();
    }
#pragma unroll
    for (int r = 0; r < 16; ++r) {
        float s = 0.f;
#pragma unroll
        for (int d = 0; d < 8; ++d) s += o[d][r];
        const float mu = half_sum32(s) * (1.0f / 256.0f);
        float q = 0.f;
#pragma unroll
        for (int d = 0; d < 8; ++d) { const float dd = o[d][r] - mu; q += dd * dd; }
        const float rstd = 1.0f / sqrtf(half_sum32(q) * (1.0f / 256.0f) + EPS);
        const size_t row = (size_t)(t0 + 32 * w + crow(r, hi));
#pragma unroll
        for (int d = 0; d < 8; ++d) { const int col = h * 256 + 32 * d + r32;
            const float z = (o[d][r] - mu) * rstd * F.g_ret[col] * bf2f(SG[row * 2048 + col]);
            RY[row * 4096 + col] = (bf16_t)(cvt_pk_bf16(z, 0.f) & 0xffffu); }
        asm volatile("" ::: "memory"); SBAR();
    }
}

constexpr int AT_BUF = 40960, AT_KP = 16384, AT_V = 24576, AT_WS = 81920;
__device__ __forceinline__ void mla_unit(Frame& F, int b, int h, int qb) {
    const int tid = opaque_tid(), lane = tid & 63, w = F_WAVE, r32 = lane & 31, hi = lane >> 5;
    const bf16_t* QN = WSP(bf16_t, WS_QN); const bf16_t* QP = WSP(bf16_t, WS_QP); const bf16_t* KN = WSP(bf16_t, WS_KN); const bf16_t* KPE = WSP(bf16_t, WS_KPE); const bf16_t* V = WSP(bf16_t, WS_V);
    bf16_t* MY = WSP(bf16_t, WS_RYMY) + 2048;
    char* lds = (char*)F.lds; const int lbase = (int)(uintptr_t)F.lds;
    float* wsf = (float*)(lds + AT_WS) + w * 64; float* li_l = wsf; float* al_l = wsf + 32;
    const size_t rb = (size_t)b * SEQ; const int q0 = qb * 256;
    bf16x8 qn[8], qp[4];
    { const size_t row = rb + q0 + 32 * w + r32;
#pragma unroll
      for (int d0 = 0; d0 < 8; ++d0) qn[d0] = *(const bf16x8*)(QN + row * 2048 + h * 128 + d0 * 16 + hi * 8);
#pragma unroll
      for (int d0 = 0; d0 < 4; ++d0) qp[d0] = *(const bf16x8*)(QP + row * 1024 + h * 64 + d0 * 16 + hi * 8); }
    const int NT = 4 * qb + 4, NTW = 4 * qb + (w >> 1) + 1;
    const int skey = tid >> 4, sc8 = (tid & 15) * 8, pkey = tid >> 3, pc8 = (tid & 7) * 8;
    u32x4 sk0, sk1, sv0, sv1, sp;
#define AT_LOAD(t) do { const size_t kb = rb + (size_t)(t) * 64; \
        sk0 = *(const u32x4*)(KN + (kb + skey) * 2048 + h * 128 + sc8); sk1 = *(const u32x4*)(KN + (kb + 32 + skey) * 2048 + h * 128 + sc8); \
        sv0 = *(const u32x4*)(V + (kb + skey) * 2048 + h * 128 + sc8);  sv1 = *(const u32x4*)(V + (kb + 32 + skey) * 2048 + h * 128 + sc8); \
        sp = *(const u32x4*)(KPE + (kb + pkey) * 64 + pc8); } while (0)
#define AT_WRITE(bf) do { char* B_ = lds + (bf) * AT_BUF; \
        *(u32x4*)(B_ + KSWZ(skey, sc8 * 2)) = sk0; *(u32x4*)(B_ + KSWZ(32 + skey, sc8 * 2)) = sk1; \
        *(u32x4*)(B_ + AT_V + v_st<4>(skey, sc8)) = sv0; *(u32x4*)(B_ + AT_V + v_st<4>(32 + skey, sc8)) = sv1; \
        *(u32x4*)(B_ + AT_KP + PSWZ(pkey, pc8 * 2)) = sp; } while (0)
    float m_reg = -1e30f, l_reg = 0.f; f32x16 o[4];
#pragma unroll
    for (int d = 0; d < 4; ++d) o[d] = f32x16{};
    AT_LOAD(0); AT_WRITE(0); __syncthreads();
    for (int t = 0; t < NT; ++t) {
        const int bf = t & 1;
        if (t + 1 < NT) AT_LOAD(t + 1);
        if (t < NTW) {
            const char* Kt = lds + bf * AT_BUF; const char* Pt = Kt + AT_KP; const int vvb = lbase + bf * AT_BUF + AT_V + v_rd_base(lane);
            f32x16 p0 = f32x16{}, p1 = f32x16{};
#pragma unroll
            for (int d0 = 0; d0 < 8; ++d0) { const int cb = (d0 * 16 + hi * 8) * 2;
                const bf16x8 k0 = *(const bf16x8*)(Kt + KSWZ(r32, cb)), k1 = *(const bf16x8*)(Kt + KSWZ(32 + r32, cb));
                p0 = __builtin_amdgcn_mfma_f32_32x32x16_bf16(k0, qn[d0], p0, 0, 0, 0); p1 = __builtin_amdgcn_mfma_f32_32x32x16_bf16(k1, qn[d0], p1, 0, 0, 0); }
#pragma unroll
            for (int d0 = 0; d0 < 4; ++d0) { const int cb = (d0 * 16 + hi * 8) * 2;
                const bf16x8 k0 = *(const bf16x8*)(Pt + PSWZ(r32, cb)), k1 = *(const bf16x8*)(Pt + PSWZ(32 + r32, cb));
                p0 = __builtin_amdgcn_mfma_f32_32x32x16_bf16(k0, qp[d0], p0, 0, 0, 0); p1 = __builtin_amdgcn_mfma_f32_32x32x16_bf16(k1, qp[d0], p1, 0, 0, 0); }
            float pmax = p0[0];
#pragma unroll
            for (int r = 1; r < 16; ++r) pmax = fmaxf(pmax, p0[r]);
#pragma unroll
            for (int r = 0; r < 16; ++r) pmax = fmaxf(pmax, p1[r]);
            { auto rr = __builtin_amdgcn_permlane32_swap(__float_as_uint(pmax), __float_as_uint(pmax), false, false); pmax = fmaxf(__uint_as_float(rr[0]), __uint_as_float(rr[1])); }
            float alpha = 1.f;
            if (!__all(pmax <= m_reg)) { const float mn = fmaxf(m_reg, pmax); alpha = fast_exp2(m_reg - mn); m_reg = mn; }
#pragma unroll
            for (int r = 0; r < 16; ++r) { p0[r] = fast_exp2(p0[r] - m_reg); p1[r] = fast_exp2(p1[r] - m_reg); }
            float ps = 0.f;
#pragma unroll
            for (int r = 0; r < 16; ++r) ps += p0[r] + p1[r];
            { auto rr = __builtin_amdgcn_permlane32_swap(__float_as_uint(ps), __float_as_uint(ps), false, false); ps = __uint_as_float(rr[0]) + __uint_as_float(rr[1]); }
            l_reg = l_reg * alpha + ps;
            if (__any(alpha < 1.f)) { if (hi == 0) al_l[r32] = alpha; LDS_WAIT();
#pragma unroll
                for (int r = 0; r < 16; ++r) { const float a = al_l[crow(r, hi)];
#pragma unroll
                    for (int d = 0; d < 4; ++d) o[d][r] *= a; } }
            bf16x8 pa0, pa1, pa2, pa3; p_to_frags(p0, p1, pa0, pa1, pa2, pa3);
            pv_one<4, 0>(o[0], vvb, pa0, pa1, pa2, pa3); pv_one<4, 1>(o[1], vvb, pa0, pa1, pa2, pa3); pv_one<4, 2>(o[2], vvb, pa0, pa1, pa2, pa3); pv_one<4, 3>(o[3], vvb, pa0, pa1, pa2, pa3);
        }
        if (t + 1 < NT) AT_WRITE(bf ^ 1);
        __syncthreads();
    }
    if (hi == 0) li_l[r32] = l_reg; LDS_WAIT();
    const size_t orow0 = rb + q0 + 32 * w;
#pragma unroll
    for (int r = 0; r < 16; ++r) { const float rl = fast_rcp(li_l[crow(r, hi)]); bf16_t* op = MY + (orow0 + crow(r, hi)) * 4096 + h * 128 + r32;
#pragma unroll
        for (int d = 0; d < 4; ++d) op[32 * d] = (bf16_t)(cvt_pk_bf16(o[d][r] * rl, 0.f) & 0xffffu); }
    __syncthreads();
#undef AT_LOAD
#undef AT_WRITE
}

#if DBG
__device__ __forceinline__ unsigned hash_u32(unsigned x) { x ^= x >> 16; x *= 0x7feb352du; x ^= x >> 15; x *= 0x846ca68bu; x ^= x >> 16; return x; }
__device__ __forceinline__ void dbg_report(Frame& F, int stage, float err, float tol) {
    const float q = err / tol; if (!(q < 1.0f)) { const int bucket = !(q < 100.f) ? 0 : q >= 30.f ? 1 : q >= 10.f ? 2 : q >= 3.f ? 3 : 4; atomicMax(WSP(unsigned, WS_CTL) + CW_ERR, (unsigned)(1000 - (stage * 10 + bucket))); }
}
__device__ __forceinline__ void dbg_code(Frame& F, int code, float err, float tol) { if (!(err / tol < 1.0f)) atomicMax(WSP(unsigned, WS_CTL) + CW_ERR, (unsigned)(1000 - code)); }
__device__ __forceinline__ float wdot(const bf16_t* a, int K, const float* W, int ldw, int col, const float* gain, int lane) {
    float s = 0.f; for (int k = lane; k < K; k += 64) { float av = bf2f(a[k]); if (gain) av *= gain[k]; s += av * W[(size_t)k * ldw + col]; } return wave_sum(s);
}
__device__ __forceinline__ void rope_cs(Frame& F, int row, int i, int half, float& c, float& s) { const float inv = powf(10000.0f, -(float)i / (float)half); sincos_acc((float)F.pos[row] * inv, s, c); }
__device__ __forceinline__ int pos128(int j) { const int n = j >> 6, i = j & 63; return 32 * (i >> 4) + 8 * ((i >> 2) & 3) + 4 * n + (i & 3); }
__device__ __forceinline__ int pos64(int j) { const int n = j >> 5, i = j & 31; return 32 * (i >> 4) + 8 * ((i >> 2) & 3) + 4 * n + (i & 3); }
__device__ __forceinline__ void chk_p0(Frame& F) {
    const size_t gt = (size_t)blockIdx.x * 512 + F_TID, NT_ = (size_t)gridDim.x * 512;
    for (size_t i = gt; i < (size_t)N1P * 2048; i += NT_) { const int c = (int)(i >> 11), k = (int)(i & 2047); const int lc = lcmap<MAP_G1>(c); const float e = lc >= 0 ? F.w_in[(size_t)k * N_IN + lc] : 0.f; dbg_code(F, 10, fabsf(bf2f(WSP(bf16_t, WS_WI)[i]) - e), 0.001f + 0.01f * fabsf(e)); }
    for (size_t i = gt; i < (size_t)3072 * 512; i += NT_) { const int c = (int)(i >> 9), k = (int)(i & 511); const float e = F.w_q_b[(size_t)k * 3072 + lcmap<MAP_Q>(c)] * F.g_qa[k]; dbg_code(F, 11, fabsf(bf2f(WSP(bf16_t, WS_WQ)[i]) - e), 0.001f + 0.01f * fabsf(e)); }
    for (size_t i = gt; i < (size_t)4096 * 512; i += NT_) { const int c = (int)(i >> 9), k = (int)(i & 511); const float e = F.w_kv_b[(size_t)k * 4096 + lcmap<MAP_KV>(c)] * F.g_kva[k]; dbg_code(F, 12, fabsf(bf2f(WSP(bf16_t, WS_WKV)[i]) - e), 0.001f + 0.01f * fabsf(e)); }
    for (size_t i = gt; i < (size_t)2048 * 4096; i += NT_) { const int c = (int)(i >> 12), k = (int)(i & 4095); const float e = k < 2048 ? F.w_ret_o[(size_t)k * 2048 + nat32(c)] : F.w_mla_o[(size_t)(k - 2048) * 2048 + nat32(c)]; dbg_code(F, 13, fabsf(bf2f(WSP(bf16_t, WS_WRM)[i]) - e), 0.001f + 0.01f * fabsf(e)); }
    for (size_t i = gt; i < (size_t)2048 * 2048; i += NT_) { const int c = (int)(i >> 11), k = (int)(i & 2047); const float e = F.w_out[(size_t)k * 2048 + nat32(c)]; dbg_code(F, 14, fabsf(bf2f(WSP(bf16_t, WS_WO)[i]) - e), 0.001f + 0.01f * fabsf(e)); }
    for (int row = blockIdx.x * 8 + F_WAVE; row < T; row += gridDim.x * 8) { float s = 0.f; for (int k = F_LANE; k < DM; k += 64) { const float v = F.x[(size_t)row * DM + k]; s += v * v; } const float rinv = 1.0f / sqrtf(wave_sum(s) / DM + EPS);
        for (int k = F_LANE; k < DM; k += 64) { const float e = F.x[(size_t)row * DM + k] * rinv * F.g_mix[k]; dbg_code(F, 15, fabsf(bf2f(WSP(bf16_t, WS_U)[(size_t)row * DM + k]) - e), 0.001f + 0.01f * fabsf(e)); } }
}
__device__ __forceinline__ void chk_p1(Frame& F) {
#ifdef SWAP_EXP
    const bf16_t* CK_SGR = WSP(bf16_t, WS_RV); const bf16_t* CK_SGM = WSP(bf16_t, WS_SG); const bf16_t* CK_RV = (const bf16_t*)F.out; const bf16_t* CK_SG = (const bf16_t*)F.out + (size_t)T * 2048;
#else
    const bf16_t* CK_SGR = (const bf16_t*)F.out; const bf16_t* CK_SGM = (const bf16_t*)F.out + (size_t)T * 2048; const bf16_t* CK_RV = WSP(bf16_t, WS_RV); const bf16_t* CK_SG = WSP(bf16_t, WS_SG);
#endif
    const int lane = F_LANE;
  for (int smp = 0; smp < 4; ++smp) {
    const int sid = (blockIdx.x * 8 + F_WAVE) * 4 + smp; const unsigned hs = hash_u32(sid * 7 + 3);
    const int row = sid; int lc = (hs >> 13) % N_IN; if (sid & 1) lc = LO_KPE + (lc & 63) ; if ((sid & 7) == 2) lc = lc % 2048;
    const bf16_t* U = WSP(bf16_t, WS_U) + (size_t)row * DM;
    float expect, got;
    if (lc < LO_RV) {
        const bool isk = lc >= LO_RK; const int l = lc - (isk ? LO_RK : 0), head = l >> 7, j = l & 127, i = j & 63; const int base = (isk ? LO_RK : 0) + head * 128;
        const float x1 = wdot(U, DM, F.w_in, N_IN, base + i, nullptr, lane), x2 = wdot(U, DM, F.w_in, N_IN, base + 64 + i, nullptr, lane); float c, s; rope_cs(F, row, i, 64, c, s);
        expect = (j < 64 ? x1 * c - x2 * s : x2 * c + x1 * s) * (isk ? RK_SCALE : 1.0f);
        got = bf2f((isk ? WSP(bf16_t, WS_RK) : WSP(bf16_t, WS_RQ))[(size_t)row * 1024 + head * 128 + pos128(j)]);
    } else if (lc >= LO_KPE && lc < LO_GRET) {
        const int j = lc - LO_KPE, i = j & 31; const float x1 = wdot(U, DM, F.w_in, N_IN, LO_KPE + i, nullptr, lane), x2 = wdot(U, DM, F.w_in, N_IN, LO_KPE + 32 + i, nullptr, lane); float c, s; rope_cs(F, row, i, 32, c, s);
        expect = j < 32 ? x1 * c - x2 * s : x2 * c + x1 * s; got = bf2f(WSP(bf16_t, WS_KPE)[(size_t)row * 64 + pos64(j)]);
    } else {
        const float v = wdot(U, DM, F.w_in, N_IN, lc, nullptr, lane);
        if (lc < LO_RG) { expect = v; got = bf2f(CK_RV[(size_t)row * 2048 + lc - LO_RV]); }
        else if (lc < LO_CQ) { expect = v / (1.0f + expf(-v)); got = bf2f(CK_SG[(size_t)row * 2048 + lc - LO_RG]); }
        else if (lc < LO_CKV) { expect = v; got = bf2f(WSP(bf16_t, WS_CQ)[(size_t)row * 512 + lc - LO_CQ]); }
        else if (lc < LO_KPE) { expect = v; got = bf2f(WSP(bf16_t, WS_CKV)[(size_t)row * 512 + lc - LO_CKV]); }
        else if (lc < LO_GMLA) { expect = 1.0f / (1.0f + expf(-v)); got = bf2f(CK_SGR[(size_t)row * 2048 + lc - LO_GRET]); }
        else { expect = 1.0f / (1.0f + expf(-v)); got = bf2f(CK_SGM[(size_t)row * 2048 + lc - LO_GMLA]); }
    }
    if (row == 6064 && lane == 0) { WSP(float, WS_CTL)[8] = got; WSP(float, WS_CTL)[9] = expect; }
    if (lc >= LO_GRET && lc < LO_GMLA && !(fabsf(got - expect) / (0.03f + 0.02f * fabsf(expect)) < 1.0f)) atomicMax(WSP(unsigned, WS_CTL) + CW_ERR + 1, 0x7fffffffu - (unsigned)(row * 2048 + (lc - LO_GRET)));
    { const int sec = lc < LO_RK ? 0 : lc < LO_RV ? 1 : lc < LO_RG ? 2 : lc < LO_CQ ? 3 : lc < LO_CKV ? 4 : lc < LO_KPE ? 5 : lc < LO_GRET ? 6 : lc < LO_GMLA ? 7 : 8; dbg_code(F, 20 + sec, fabsf(got - expect), 0.03f + 0.02f * fabsf(expect)); }
    {
        float sq = 0.f, sk = 0.f; for (int k = lane; k < 512; k += 64) { const float a = bf2f(WSP(bf16_t, WS_CQ)[(size_t)row * 512 + k]), b2 = bf2f(WSP(bf16_t, WS_CKV)[(size_t)row * 512 + k]); sq += a * a; sk += b2 * b2; }
        sq = wave_sum(sq); sk = wave_sum(sk);
        dbg_code(F, 29, fabsf(WSP(float, WS_CTL + CTL_SSQ_Q)[row] - sq), 0.02f * sq + 1e-3f); dbg_code(F, 29, fabsf(WSP(float, WS_CTL + CTL_SSQ_KV)[row] - sk), 0.02f * sk + 1e-3f);
    }
  }
}
__device__ __forceinline__ void chk_p2(Frame& F) {
    const int lane = F_LANE;
  for (int smp = 0; smp < 4; ++smp) {
    const int sid = (blockIdx.x * 8 + F_WAVE) * 4 + smp; const unsigned hs = hash_u32(sid * 11 + 5);
    const int row = sid, h = (hs >> 13) & 15, d = (hs >> 17) % 192, which = (hs >> 25) % 3;
    const bf16_t* cq = WSP(bf16_t, WS_CQ) + (size_t)row * 512; const bf16_t* ckv = WSP(bf16_t, WS_CKV) + (size_t)row * 512;
    float expect, got;
    if (which == 0) {
        float s = 0.f; for (int k = lane; k < 512; k += 64) { const float a = bf2f(cq[k]); s += a * a; } const float rinv = 1.0f / sqrtf(wave_sum(s) / 512.f + EPS);
        if (d < 128) { expect = wdot(cq, 512, F.w_q_b, 3072, h * 192 + d, F.g_qa, lane) * rinv * C2Q; got = bf2f(WSP(bf16_t, WS_QN)[(size_t)row * 2048 + h * 128 + d]); }
        else { const int j = d - 128, i = j & 31; const float x1 = wdot(cq, 512, F.w_q_b, 3072, h * 192 + 128 + i, F.g_qa, lane), x2 = wdot(cq, 512, F.w_q_b, 3072, h * 192 + 160 + i, F.g_qa, lane); float c, sn; rope_cs(F, row, i, 32, c, sn);
            expect = (j < 32 ? x1 * c - x2 * sn : x2 * c + x1 * sn) * rinv * C2Q; got = bf2f(WSP(bf16_t, WS_QP)[(size_t)row * 1024 + h * 64 + pos64(j)]); }
        dbg_report(F, 3, fabsf(got - expect), 0.03f * C2Q * 4.f + 0.02f * fabsf(expect));
    } else {
        float s = 0.f; for (int k = lane; k < 512; k += 64) { const float a = bf2f(ckv[k]); s += a * a; } const float rinv = 1.0f / sqrtf(wave_sum(s) / 512.f + EPS);
        const int dd = d & 127;
        expect = wdot(ckv, 512, F.w_kv_b, 4096, h * 256 + (which == 2 ? 128 : 0) + dd, F.g_kva, lane) * rinv; got = bf2f((which == 2 ? WSP(bf16_t, WS_V) : WSP(bf16_t, WS_KN))[(size_t)row * 2048 + h * 128 + dd]);
        dbg_report(F, 3, fabsf(got - expect), 0.03f + 0.02f * fabsf(expect));
    }
  }
}
__device__ __forceinline__ void chk_ret(Frame& F) {
    const int tid = F_TID; float* sc = (float*)(char*)F.lds; float* red = sc + 4096;
    const bf16_t* RQ = WSP(bf16_t, WS_RQ); const bf16_t* RK = WSP(bf16_t, WS_RK); const bf16_t* RV = WSP(bf16_t, WS_RV);
    for (int smp = 0; smp < 32; ++smp) {
        const int grow = blockIdx.x * 32 + smp; const unsigned hs = hash_u32(grow * 13 + 7); const int b = grow >> 12, n = grow & 4095, h = hs & 7;
        const size_t rb = (size_t)b * SEQ; const int pend = (n / 64 + 1) * 64; const float lg = log2gamma(h);
        const bf16_t* q = RQ + (rb + n) * 1024 + h * 128;
        for (int p = tid; p < pend; p += 512) { const bf16_t* k = RK + (rb + p) * 1024 + h * 128; float s = 0.f; for (int d = 0; d < 128; ++d) s += bf2f(q[d]) * bf2f(k[d]); sc[p] = s * exp2f(lg * fabsf((float)(n - p))); }
        __syncthreads();
        float o = 0.f;
        if (tid < 256) { for (int p = 0; p < pend; ++p) o += sc[p] * bf2f(RV[(rb + p) * 2048 + h * 256 + tid]); red[tid] = o; }
        __syncthreads();
        if (tid < 256) { float mu = 0.f; for (int i = 0; i < 256; ++i) mu += red[i]; mu /= 256.f; float var = 0.f; for (int i = 0; i < 256; ++i) { const float dd = red[i] - mu; var += dd * dd; } var /= 256.f;
            const float expect = (o - mu) / sqrtf(var + EPS) * F.g_ret[h * 256 + tid] * bf2f(WSP(bf16_t, WS_SG)[(rb + n) * 2048 + h * 256 + tid]);
            const float got = bf2f(WSP(bf16_t, WS_RYMY)[(rb + n) * 4096 + h * 256 + tid]);
            dbg_report(F, 4, fabsf(got - expect), 0.04f + 0.03f * fabsf(expect)); }
        __syncthreads();
    }
}
__device__ __forceinline__ void chk_mla(Frame& F) {
    const int tid = F_TID; float* sc = (float*)(char*)F.lds; float* red = sc + 4096;
    for (int smp = 0; smp < 32; ++smp) {
        const int grow = blockIdx.x * 32 + smp; const unsigned hs = hash_u32(grow * 17 + 9); const int b = grow >> 12, n = grow & 4095, h = hs & 15;
        const size_t rb = (size_t)b * SEQ; const int pend = (n / 64 + 1) * 64;
        const bf16_t* qn = WSP(bf16_t, WS_QN) + (rb + n) * 2048 + h * 128; const bf16_t* qp = WSP(bf16_t, WS_QP) + (rb + n) * 1024 + h * 64;
        for (int p = tid; p < pend; p += 512) { const bf16_t* kn = WSP(bf16_t, WS_KN) + (rb + p) * 2048 + h * 128; const bf16_t* kp = WSP(bf16_t, WS_KPE) + (rb + p) * 64; float s = 0.f;
            for (int d = 0; d < 128; ++d) s += bf2f(qn[d]) * bf2f(kn[d]); for (int d = 0; d < 64; ++d) s += bf2f(qp[d]) * bf2f(kp[d]); sc[p] = s; }
        __syncthreads();
        float o = 0.f, l = 0.f;
        if (tid < 128) { float mx = -1e30f; for (int p = 0; p < pend; ++p) mx = fmaxf(mx, sc[p]);
            for (int p = 0; p < pend; ++p) { const float e = exp2f(sc[p] - mx); l += e; o += e * bf2f(WSP(bf16_t, WS_V)[(rb + p) * 2048 + h * 128 + tid]); }
            o /= l; red[tid] = fabsf(o); }
        __syncthreads();
        if (tid < 128) { float mxa = 0.f; for (int i = 0; i < 128; ++i) mxa = fmaxf(mxa, red[i]);
            const float got = bf2f(WSP(bf16_t, WS_RYMY)[(rb + n) * 4096 + 2048 + h * 128 + tid]);
            dbg_report(F, 5, fabsf(got - o), 0.03f * mxa + 0.02f * fabsf(o)); }
        __syncthreads();
    }
}
__device__ __forceinline__ void chk_sgr_full(Frame& F) {
    unsigned* ctl = WSP(unsigned, WS_CTL); const bf16_t* SGRp = (const bf16_t*)F.out;
    const int colb = (blockIdx.x & 7) * 256 + (F_TID & 255), rhalf = F_TID >> 8;
    const int rowb = (blockIdx.x >> 3) * 256;
    for (int rr = 0; rr < 128; rr += 8) {
        float acc[8]; for (int j = 0; j < 8; ++j) acc[j] = 0.f;
        const int r0 = rowb + rhalf * 128 + rr;
        for (int k = 0; k < DM; ++k) { const float w = F.w_in[(size_t)k * N_IN + LO_GRET + colb];
#pragma unroll
            for (int j = 0; j < 8; ++j) acc[j] += bf2f(WSP(bf16_t, WS_U)[(size_t)(r0 + j) * DM + k]) * w; }
#pragma unroll
        for (int j = 0; j < 8; ++j) { const float e = 1.0f / (1.0f + expf(-acc[j])), g = bf2f(SGRp[(size_t)(r0 + j) * 2048 + colb]);
            if (!(fabsf(g - e) < 0.03f)) { atomicAdd(ctl + 16, 1u); atomicAdd(ctl + 32 + (((r0 + j) >> 8) * 8 + (colb >> 8)), 1u); atomicAdd(ctl + 288 + ((r0 + j) & 255), 1u); } }
    }
}
__device__ __forceinline__ void chk_p5(Frame& F) {
    const int lane = F_LANE;
    for (int smp = 0; smp < 4; ++smp) { const int row = (blockIdx.x * 8 + F_WAVE) * 4 + smp; const unsigned hs = hash_u32(row * 19 + 11); const int col = hs % 2048;
        const bf16_t* ry = WSP(bf16_t, WS_RYMY) + (size_t)row * 4096;
        const float y1 = wdot(ry, 2048, F.w_ret_o, 2048, col, nullptr, lane), y2 = wdot(ry + 2048, 2048, F.w_mla_o, 2048, col, nullptr, lane);
        const float g1 = bf2f(((const bf16_t*)F.out)[(size_t)row * 2048 + col]), g2 = bf2f(((const bf16_t*)F.out + (size_t)T * 2048)[(size_t)row * 2048 + col]);
        const float expect = g1 * y1 + g2 * y2, got = bf2f(WSP(bf16_t, WS_MERGED)[(size_t)row * 2048 + col]);
        dbg_report(F, 6, fabsf(got - expect), 0.02f + 0.02f * fabsf(expect)); }
    const unsigned hs = hash_u32((blockIdx.x * 8 + F_WAVE) * 64 + lane + 77);
    { const int c = hs % 8192, k = (hs >> 16) % 2048; const float e = F.w_up[(size_t)k * 8192 + nat32(c)] * F.g_mlp[k]; dbg_report(F, 6, fabsf(bf2f(WSP(bf16_t, WS_WU)[(size_t)c * 2048 + k]) - e), 0.001f + 0.01f * fabsf(e)); }
    { const int c = hs % 2048, k = (hs >> 16) % 8192; const float e = F.w_down[(size_t)k * 2048 + nat32(c)]; dbg_report(F, 6, fabsf(bf2f(WSP(bf16_t, WS_WD)[(size_t)c * 8192 + k]) - e), 0.001f + 0.01f * fabsf(e)); }
}
__device__ __forceinline__ void chk_p6(Frame& F) {
    const int lane = F_LANE;
    for (int smp = 0; smp < 4; ++smp) { const int row = (blockIdx.x * 8 + F_WAVE) * 4 + smp; const unsigned hs = hash_u32(row * 23 + 13); const int col = hs % 2048;
        const float expect = F.x[(size_t)row * 2048 + col] + wdot(WSP(bf16_t, WS_MERGED) + (size_t)row * 2048, 2048, F.w_out, 2048, col, nullptr, lane);
        dbg_report(F, 7, fabsf(F.out[(size_t)row * 2048 + col] - expect), 0.02f + 0.02f * fabsf(expect));
        dbg_report(F, 7, fabsf(bf2f(WSP(bf16_t, WS_H1B)[(size_t)row * 2048 + col]) - expect), 0.03f + 0.02f * fabsf(expect));
        float s = 0.f; for (int k = lane; k < 2048; k += 64) { const float v = F.out[(size_t)row * 2048 + k]; s += v * v; } s = wave_sum(s);
        dbg_report(F, 7, fabsf(WSP(float, WS_CTL + CTL_SSQ_H1)[row] - s), 0.01f * s + 1e-3f); }
}
__device__ __forceinline__ void chk_p7(Frame& F) {
    const int lane = F_LANE;
    for (int smp = 0; smp < 4; ++smp) { const int row = (blockIdx.x * 8 + F_WAVE) * 4 + smp; const unsigned hs = hash_u32(row * 29 + 15); const int col = hs % 8192;
        const float rinv = 1.0f / sqrtf(WSP(float, WS_CTL + CTL_SSQ_H1)[row] / 2048.f + EPS);
        const float z = wdot(WSP(bf16_t, WS_H1B) + (size_t)row * 2048, 2048, F.w_up, 8192, col, F.g_mlp, lane) * rinv; const float r = fmaxf(z, 0.f), expect = r * r;
        dbg_report(F, 8, fabsf(bf2f(WSP(bf16_t, WS_HMID)[(size_t)row * 8192 + col]) - expect), 0.04f + 0.03f * fabsf(expect)); }
}
__device__ __forceinline__ void chk_p8(Frame& F) {
    const int lane = F_LANE;
    for (int smp = 0; smp < 4; ++smp) { const int row = (blockIdx.x * 8 + F_WAVE) * 4 + smp; const unsigned hs = hash_u32(row * 31 + 17); const int col = hs % 2048;
        const float expect = bf2f(WSP(bf16_t, WS_H1B)[(size_t)row * 2048 + col]) + wdot(WSP(bf16_t, WS_HMID) + (size_t)row * 8192, 8192, F.w_down, 2048, col, nullptr, lane);
        dbg_report(F, 9, fabsf(F.out[(size_t)row * 2048 + col] - expect), 0.05f + 0.03f * fabsf(expect));
        float s = 0.f; for (int k = lane; k < 2048; k += 64) { const float v = F.out[(size_t)row * 2048 + k]; s += v * v; } s = wave_sum(s);
        dbg_report(F, 9, fabsf(WSP(float, WS_CTL + CTL_SSQ_H2)[row] - s), 0.01f * s + 1e-3f); }
}
#endif

constexpr int N_PHASES = 10;
struct Args { const void* in[16]; float* out; unsigned char* ws; int ph_lo, ph_hi; };
__global__ void __launch_bounds__(512, 2) fwd_megakernel(Args args) {
    extern __shared__ __attribute__((aligned(16))) unsigned char lds_raw[];
    Frame F;
    F.lds = (LAS unsigned char*)lds_raw;

    F.G = gridDim.x; { const int bx = blockIdx.x; F.vcu = (F.G % 8 == 0) ? (bx % 8) * (F.G / 8) + bx / 8 : bx; }
    F.ws = args.ws; F.out = args.out;
    F.x = (const float*)args.in[0]; F.pos = (const int*)args.in[1]; F.g_mix = (const float*)args.in[2]; F.w_in = (const float*)args.in[3]; F.g_ret = (const float*)args.in[4];
    F.w_ret_o = (const float*)args.in[5]; F.g_qa = (const float*)args.in[6]; F.w_q_b = (const float*)args.in[7]; F.g_kva = (const float*)args.in[8]; F.w_kv_b = (const float*)args.in[9];
    F.w_mla_o = (const float*)args.in[10]; F.w_out = (const float*)args.in[11]; F.g_mlp = (const float*)args.in[12]; F.w_up = (const float*)args.in[13]; F.w_down = (const float*)args.in[14]; F.g_f = (const float*)args.in[15];
    volatile LAS unsigned* MISC = (volatile LAS unsigned*)(F.lds + MISC_OFF);
    for (int u = F_TID; u < (LDS_BYTES - RING_BYTES) / 4; u += 512) ((LAS unsigned*)(F.lds + RING_BYTES))[u] = 0u;
    __syncthreads();
    unsigned* ctl = WSP(unsigned, WS_CTL);
    const int lo = args.ph_lo, hi = args.ph_hi;
    XcdBarrier bar; bar.bar = ctl + CW_BAR; bar.x = 0; bar.st = nullptr;
    if (hi - lo > 1) bar = xcd_barrier_post(ctl + CW_BAR, MISC + 8);
#ifndef PH_MASK
#define PH_MASK 0x3ff
#endif
#define IN(k) ((((PH_MASK) >> (k)) & 1) && lo <= (k) && (k) < hi)
#define SEAM(k) do { if (lo <= (k) && (k) + 1 < hi) xcd_barrier(bar); } while (0)
    float* ssq_q = WSP(float, WS_CTL + CTL_SSQ_Q); float* ssq_kv = WSP(float, WS_CTL + CTL_SSQ_KV); float* ssq_h1 = WSP(float, WS_CTL + CTL_SSQ_H1); float* ssq_h2 = WSP(float, WS_CTL + CTL_SSQ_H2);
#ifdef SWAP_EXP
    bf16_t* SGR = WSP(bf16_t, WS_RV); bf16_t* SGM = WSP(bf16_t, WS_SG); bf16_t* P_RV = (bf16_t*)F.out; bf16_t* P_SG = (bf16_t*)F.out + (size_t)T * 2048;
#else
    bf16_t* SGR = (bf16_t*)F.out; bf16_t* SGM = (bf16_t*)F.out + (size_t)T * 2048; bf16_t* P_RV = WSP(bf16_t, WS_RV); bf16_t* P_SG = WSP(bf16_t, WS_SG);
#endif
    const int c = (int)blockIdx.x;

#ifdef START_DELAY_US
    if (lo == 0) { const unsigned long long t0 = __builtin_amdgcn_s_memrealtime(); while (__builtin_amdgcn_s_memrealtime() - t0 < (unsigned long long)(START_DELAY_US) * 100ull) __builtin_amdgcn_s_sleep(32); }
#endif
    if (IN(0)) { p0_prologue(F); }
#if (REPMASK >> 0) & 1
    SBAR(); asm volatile("" ::: "memory");
    if (IN(0)) { p0_prologue(F); }
#endif
    SEAM(0);
#if DBG
    if (IN(1)) { chk_p0(F); if (hi - lo > 1) xcd_barrier(bar); }
#endif
    if (IN(1)) {
        SchedG1 S{F.G, c, (const char*)WSP(bf16_t, WS_U), (const char*)WSP(bf16_t, WS_WI)};
        EpiG1 E{WSP(bf16_t, WS_RQ), WSP(bf16_t, WS_RK), P_RV, P_SG, WSP(bf16_t, WS_CQ), WSP(bf16_t, WS_CKV), WSP(bf16_t, WS_KPE), SGR, SGM,
                WSP(float, WS_RC64), WSP(float, WS_RS64), WSP(float, WS_RC32), WSP(float, WS_RS32), ssq_q, ssq_kv};
        pg8::gemm_phase<EpiG1, SchedG1, true>(F.lds, 2048, 2048, 32, S, E);
    }
    SEAM(1);
#if DBG
    if (IN(2)) { chk_p1(F); if (hi - lo > 1) xcd_barrier(bar); }
#endif
    if (IN(2)) {
        SchedG2 S{F.G, c, (const char*)WSP(bf16_t, WS_CQ), (const char*)WSP(bf16_t, WS_CKV), (const char*)WSP(bf16_t, WS_WQ), (const char*)WSP(bf16_t, WS_WKV)};
        EpiG2 E{WSP(bf16_t, WS_QN), WSP(bf16_t, WS_QP), WSP(bf16_t, WS_KN), WSP(bf16_t, WS_V), WSP(float, WS_RC32), WSP(float, WS_RS32), ssq_q, ssq_kv};
        pg8::gemm_phase<EpiG2, SchedG2, true>(F.lds, 512, 512, 8, S, E);
        __syncthreads();
        if (c >= F.G / 2) for (int u = c - F.G / 2; u < 256; u += F.G / 2) ret_local_unit(F, u);
    }
#if (REPMASK >> 2) & 1
    SBAR(); asm volatile("" ::: "memory");
    if (IN(2)) {
        SchedG2 S{F.G, c, (const char*)WSP(bf16_t, WS_CQ), (const char*)WSP(bf16_t, WS_CKV), (const char*)WSP(bf16_t, WS_WQ), (const char*)WSP(bf16_t, WS_WKV)};
        EpiG2 E{WSP(bf16_t, WS_QN), WSP(bf16_t, WS_QP), WSP(bf16_t, WS_KN), WSP(bf16_t, WS_V), WSP(float, WS_RC32), WSP(float, WS_RS32), ssq_q, ssq_kv};
        pg8::gemm_phase<EpiG2, SchedG2, true>(F.lds, 512, 512, 8, S, E);
        __syncthreads();
        if (c >= F.G / 2) for (int u = c - F.G / 2; u < 256; u += F.G / 2) ret_local_unit(F, u);
    }
#endif
    SEAM(2);
#if DBG
    if (IN(3)) { chk_p2(F); if (hi - lo > 1) xcd_barrier(bar); }
#endif
    if (IN(3)) ret_scan(F);
    SEAM(3);
#ifndef REP4
#define REP4 1
#endif
    if (IN(4)) {
        const int hb = F.vcu >> 3, pr = F.vcu & 7;
#ifndef NO_RETOUT
        for (int u = F.vcu; u < 256; u += F.G) ret_out_unit(F, u);
#endif
        __syncthreads();
#ifndef NO_MLA
        if (F.vcu < 256) { mla_unit(F, hb >> 4, hb & 15, 15 - pr); mla_unit(F, hb >> 4, hb & 15, pr); }
#endif
    }
#if REP4 == 2
    SBAR(); asm volatile("" ::: "memory");
    if (IN(4)) {
        const int hb = F.vcu >> 3, pr = F.vcu & 7;
#ifndef NO_RETOUT
        for (int u = F.vcu; u < 256; u += F.G) ret_out_unit(F, u);
#endif
        __syncthreads();
#ifndef NO_MLA
        if (F.vcu < 256) { mla_unit(F, hb >> 4, hb & 15, 15 - pr); mla_unit(F, hb >> 4, hb & 15, pr); }
#endif
    }
#endif
    SEAM(4);
#if DBG
    if (IN(5)) { chk_ret(F); chk_mla(F); if (hi - lo > 1) xcd_barrier(bar); }
#endif
    if (IN(5)) {
        p5_convert(F);
        __syncthreads();
        SchedG5 S{F.G, c, (const char*)WSP(bf16_t, WS_RYMY), (const char*)WSP(bf16_t, WS_WRM)};
        EpiG5 E{SGR, SGM, WSP(bf16_t, WS_MERGED)};
        pg8::gemm_phase<EpiG5, SchedG5, false>(F.lds, 4096, 4096, 32, S, E);
    }
#if (REPMASK >> 5) & 1
    SBAR(); asm volatile("" ::: "memory");
    if (IN(5)) {
        p5_convert(F);
        __syncthreads();
        SchedG5 S{F.G, c, (const char*)WSP(bf16_t, WS_RYMY), (const char*)WSP(bf16_t, WS_WRM)};
        EpiG5 E{SGR, SGM, WSP(bf16_t, WS_MERGED)};
        pg8::gemm_phase<EpiG5, SchedG5, false>(F.lds, 4096, 4096, 32, S, E);
    }
#endif
    SEAM(5);
#if DBG
    if (IN(6)) { chk_p5(F); if (hi - lo > 1) xcd_barrier(bar); }
#endif
    if (IN(6)) {
        SchedN S{F.G, c, 8, (const char*)WSP(bf16_t, WS_MERGED), (const char*)WSP(bf16_t, WS_WO), (size_t)256 * 2048 * 2, (size_t)256 * 2048 * 2};
        EpiG6 E{F.x, F.out, WSP(bf16_t, WS_H1B), ssq_h1};
        pg8::gemm_phase<EpiG6, SchedN, false>(F.lds, 2048, 2048, 32, S, E);
    }
    SEAM(6);
#if DBG
    if (IN(7)) { chk_p6(F); if (hi - lo > 1) xcd_barrier(bar); }
#endif
    if (IN(7)) {
        SchedN S{F.G, c, 32, (const char*)WSP(bf16_t, WS_H1B), (const char*)WSP(bf16_t, WS_WU), (size_t)256 * 2048 * 2, (size_t)256 * 2048 * 2};
        EpiG7 E{WSP(bf16_t, WS_HMID), ssq_h1};
        pg8::gemm_phase<EpiG7, SchedN, true>(F.lds, 2048, 2048, 32, S, E);
    }
#if (REPMASK >> 7) & 1
    SBAR(); asm volatile("" ::: "memory");
    if (IN(7)) {
        SchedN S{F.G, c, 32, (const char*)WSP(bf16_t, WS_H1B), (const char*)WSP(bf16_t, WS_WU), (size_t)256 * 2048 * 2, (size_t)256 * 2048 * 2};
        EpiG7 E{WSP(bf16_t, WS_HMID), ssq_h1};
        pg8::gemm_phase<EpiG7, SchedN, true>(F.lds, 2048, 2048, 32, S, E);
    }
#endif
    SEAM(7);
#if DBG
    if (IN(8)) { chk_p7(F); if (hi - lo > 1) xcd_barrier(bar); }
#endif
    if (IN(8)) {
        SchedN S{F.G, c, 8, (const char*)WSP(bf16_t, WS_HMID), (const char*)WSP(bf16_t, WS_WD), (size_t)256 * 8192 * 2, (size_t)256 * 8192 * 2};
        EpiG8 E{F.out, ssq_h2};
        pg8::gemm_phase<EpiG8, SchedN, false>(F.lds, 8192, 8192, 128, S, E);
    }
    SEAM(8);
#if DBG
    if (IN(9)) { chk_p8(F); if (hi - lo > 1) xcd_barrier(bar); }
#endif
    if (IN(9)) {
        const int gw = F.vcu * 8 + F_WAVE, NGW = F.G * 8;
#if DBG
        const unsigned ev = __hip_atomic_load(ctl + CW_ERR, __ATOMIC_RELAXED, __HIP_MEMORY_SCOPE_AGENT);
        const unsigned bt = __hip_atomic_load(ctl + CW_BAR + XB_TMO, __ATOMIC_RELAXED, __HIP_MEMORY_SCOPE_AGENT);
        float xfill0 = 0.f; float fill = bt ? sqrtf(98.f) : (ev ? sqrtf((float)(1000 - (int)ev)) : 0.f);
        { const unsigned iw = __hip_atomic_load(ctl + CW_ERR + 1, __ATOMIC_RELAXED, __HIP_MEMORY_SCOPE_AGENT);
          const float xg = __hip_atomic_load(WSP(float, WS_CTL) + 8, __ATOMIC_RELAXED, __HIP_MEMORY_SCOPE_AGENT), xe = __hip_atomic_load(WSP(float, WS_CTL) + 9, __ATOMIC_RELAXED, __HIP_MEMORY_SCOPE_AGENT);
          (void)xg; (void)xe;
#ifdef ONLY_STAGE1
          { const unsigned cnt = __hip_atomic_load(ctl + 16, __ATOMIC_RELAXED, __HIP_MEMORY_SCOPE_AGENT); unsigned nbt = 0, mx = 0; for (int i = 0; i < 256; ++i) { const unsigned v = __hip_atomic_load(ctl + 32 + i, __ATOMIC_RELAXED, __HIP_MEMORY_SCOPE_AGENT); nbt += v ? 1u : 0u; mx = v > mx ? v : mx; }
            (void)cnt; fill = sqrtf((10.f + floorf((float)nbt * 0.25f)) * 1e6f); xfill0 = (10.f + 2.f * floorf(log2f((float)mx + 1.f))) * 1e4f; }
#endif
          if (iw && false) { const unsigned rc = 0x7fffffffu - iw; const int row = rc >> 11, col = rc & 2047; const int mval = 10 + (row >> 8), ex = 1 + ((row >> 5) & 7); (void)col; fill = sqrtf((float)mval * __powf(10.f, (float)ex)); } }
#endif
        for (int m = gw; m < T; m += NGW) {
            f32x4* xr = (f32x4*)(F.out + (size_t)m * DM) + F_LANE; const f32x4* gr = (const f32x4*)F.g_f + F_LANE;
            const float rinv = 1.0f / sqrtf(ssq_h2[m] * (1.f / DM) + EPS);
#pragma unroll
            for (int j = 0; j < 8; ++j) { f32x4 v = xr[64 * j] * rinv * gr[64 * j];
#if DBG
                if (fill != 0.f) v = (f32x4){fill, fill, fill, fill};
                if (xfill0 != 0.f && m == 0 && j == 0 && F_LANE == 0) v[0] = xfill0;
#endif
                xr[64 * j] = v; }
        }
    }
#undef IN
#undef SEAM
}

extern "C" void kernel_launch(void* const* d_in, const int* in_sizes, int n_in, void* d_out, int out_size, void* d_ws, size_t ws_size, hipStream_t stream) {
    static int grid = 0;
    if (grid == 0) {
        if (n_in != 16 || out_size != T * DM || ws_size < WS_END) { fprintf(stderr, "kernel_launch: unexpected shapes (n_in %d, out %d, ws %zu < %zu)\n", n_in, out_size, ws_size, (size_t)WS_END); grid = -1; return; }
        int dev = 0, cus = 0, per_cu = 0;
        hipGetDevice(&dev); hipDeviceGetAttribute(&cus, hipDeviceAttributeMultiprocessorCount, dev);
        if (hipFuncSetAttribute((const void*)fwd_megakernel, hipFuncAttributeMaxDynamicSharedMemorySize, LDS_BYTES) != hipSuccess) { fprintf(stderr, "kernel_launch: hipFuncSetAttribute failed\n"); grid = -1; return; }
        hipOccupancyMaxActiveBlocksPerMultiprocessor(&per_cu, (const void*)fwd_megakernel, 512, LDS_BYTES);
        (void)hipGetLastError();
        if (per_cu < 1) { fprintf(stderr, "kernel_launch: occupancy query says %d blocks per CU\n", per_cu); grid = -1; return; }
        grid = cus;
        if (grid > 256) grid = 256;
    }
    if (grid < 0) return;
    hipMemsetAsync((char*)d_ws + WS_CTL, 0, CTL_BYTES, stream);
    Args a{};
    for (int i = 0; i < 16; ++i) a.in[i] = d_in[i];
    a.out = (float*)d_out; a.ws = (unsigned char*)d_ws;
#if N_LAUNCH_SPLIT
    for (int p = 0; p < N_PHASES; ++p) { a.ph_lo = p; a.ph_hi = p + 1; hipLaunchKernelGGL(fwd_megakernel, dim3(grid), dim3(512), LDS_BYTES, stream, a); }
#else
    a.ph_lo = 0; a.ph_hi = N_PHASES;
    void* kargs[] = {&a};
    hipError_t e = hipLaunchCooperativeKernel((const void*)fwd_megakernel, dim3(grid), dim3(512), kargs, LDS_BYTES, stream);
    if (e != hipSuccess) fprintf(stderr, "kernel_launch: cooperative launch failed: %s (grid %d)\n", hipGetErrorString(e), grid);
#endif
}
```
